# Optimizing an MI355X kernel written in HIP

```python
import math
import jax, jax.numpy as jnp
from jax import lax
import numpy as np

D_MODEL = 2048
BATCH = 4
SEQ = 2048
DEPTH = 4
DEC_BATCH = 8
DEC_SEQ = 1
PAST_LEN = 16384
PAGE_SIZE = 128

N_MIXERS = 2
N_ATTN_LAYERS = (DEPTH + 1) // 2
N_SSM_LAYERS = DEPTH // 2
HEAD_DIM = 128
HEADS_PER_GROUP = D_MODEL // (2 * HEAD_DIM)
DIL_GROUPS = ((128, 1), (512, 4), (2048, 16))
N_DIL = len(DIL_GROUPS)
ROT_DIM = HEAD_DIM // 4
ROPE_THETA = 500000.0
Q_BLOCK = 128
NEG_INF = -1e30
D_SSM = D_MODEL
SSM_CH = 16
SSM_GROUPS = D_SSM // SSM_CH
SSM_STATE = 64
DT_MIN = 0.001
DT_MAX = 0.1
D_FF = ((8 * D_MODEL // 3 + 127) // 128) * 128
CONV_WIDTH = 3
RMS_EPS = 1e-6

kernel_name = "dilated_swa_s5_convffn_hybrid_step"


def rms_norm(x, g):
    xf = x.astype(jnp.float32)
    y = xf * lax.rsqrt(jnp.mean(xf * xf, axis=-1, keepdims=True) + RMS_EPS)
    return (y * g.astype(jnp.float32)).astype(x.dtype)


def rope_partial(x, pos):
    half = ROT_DIM // 2
    inv = ROPE_THETA ** (-(jnp.arange(half, dtype=jnp.float32) * (2.0 / ROT_DIM)))
    ang = pos.astype(jnp.float32)[:, None] * inv[None, :]
    cos = jnp.cos(ang)[None, :, None, None, :]
    sin = jnp.sin(ang)[None, :, None, None, :]
    xf = x.astype(jnp.float32)
    x1, x2 = xf[..., :half], xf[..., half:ROT_DIM]
    out = jnp.concatenate([x1 * cos - x2 * sin, x2 * cos + x1 * sin, xf[..., ROT_DIM:]], axis=-1)
    return out.astype(x.dtype)


def qkv_project(h, w_qkv, pos):
    B, T, _ = h.shape
    qkv = (h @ w_qkv).reshape(B, T, 3, N_DIL, HEADS_PER_GROUP, HEAD_DIM)
    q = rope_partial(qkv[:, :, 0], pos)
    k = rope_partial(qkv[:, :, 1], pos)
    v = qkv[:, :, 2]
    return q, k, v


def dilated_attend(q, k_all, v_all, q_idx, dilation, n_back):
    key_idx = q_idx[:, None] - dilation * jnp.arange(n_back + 1)[None, :]
    valid = key_idx >= 0
    key_idx = jnp.maximum(key_idx, 0)
    kg = jnp.take(k_all, key_idx, axis=1)
    vg = jnp.take(v_all, key_idx, axis=1)
    s = jnp.einsum('bqhd,bqkhd->bqhk', q, kg, preferred_element_type=jnp.float32) * (HEAD_DIM ** -0.5)
    s = jnp.where(valid[None, :, None, :], s, NEG_INF)
    m = jnp.max(s, axis=-1, keepdims=True)
    p = jnp.exp(s - m)
    l = jnp.sum(p, axis=-1, keepdims=True)
    o = jnp.einsum('bqhk,bqkhd->bqhd', p, vg.astype(jnp.float32)) / jnp.swapaxes(l, -1, -2)[..., 0][..., None]
    lse = (m + jnp.log(l))[..., 0]
    return o, lse


def merge_by_denominator(outs, lses):
    w = jax.nn.softmax(jnp.stack(lses, axis=0), axis=0)
    return jnp.sum(w[..., None] * jnp.stack(outs, axis=0), axis=0)


def attn_prompt(h, w_qkv, w_o):
    B, T, _ = h.shape
    q, k, v = qkv_project(h, w_qkv, jnp.arange(T))
    qs = [q[:, :, g] for g in range(N_DIL)]
    ks = [k[:, :, g] for g in range(N_DIL)]
    vs = [v[:, :, g] for g in range(N_DIL)]

    def block(start):
        idx = start + jnp.arange(Q_BLOCK)
        outs, lses = [], []
        for g, (win, dil) in enumerate(DIL_GROUPS):
            qb = lax.dynamic_slice_in_dim(qs[g], start, Q_BLOCK, axis=1)
            o, lse = dilated_attend(qb, ks[g], vs[g], idx, dil, win // dil)
            outs.append(o)
            lses.append(lse)
        return merge_by_denominator(outs, lses)

    o = lax.map(block, jnp.arange(0, T, Q_BLOCK))
    o = jnp.moveaxis(o, 0, 1).reshape(B, T, HEADS_PER_GROUP * HEAD_DIM).astype(h.dtype)
    new_kv = []
    for g, (win, _) in enumerate(DIL_GROUPS):
        keep = min(win, T)
        new_kv.append(jnp.stack([ks[g][:, T - keep:], vs[g][:, T - keep:]], axis=2))
    return o @ w_o, new_kv


def attn_sample(h, kv_bufs, w_qkv, w_o):
    B, S, _ = h.shape
    q, k, v = qkv_project(h, w_qkv, PAST_LEN + jnp.arange(S))
    outs, lses, new_rows = [], [], []
    for g, (win, dil) in enumerate(DIL_GROUPS):
        buf = kv_bufs[g]
        L = buf.shape[1]
        k_all = jnp.concatenate([buf[:, :, 0].astype(k.dtype), k[:, :, g]], axis=1)
        v_all = jnp.concatenate([buf[:, :, 1].astype(v.dtype), v[:, :, g]], axis=1)
        o, lse = dilated_attend(q[:, :, g], k_all, v_all, L + jnp.arange(S), dil, win // dil)
        outs.append(o)
        lses.append(lse)
        new_rows.append(jnp.stack([k[:, :, g], v[:, :, g]], axis=2))
    o = merge_by_denominator(outs, lses).reshape(B, S, HEADS_PER_GROUP * HEAD_DIM).astype(h.dtype)
    return o @ w_o, new_rows


def _linear_recurrence_combine(e1, e2):
    a1, b1 = e1
    a2, b2 = e2
    return a1 * a2, a2 * b1 + b2


def s5_mixer(h, h0, w_in, lam_re, lam_im, log_dt, b_re, b_im, c_re, c_im, d_skip, w_glu):
    B, T, _ = h.shape
    f32 = jnp.float32
    u = (h @ w_in).astype(f32)
    ug = u.reshape(B, T, SSM_GROUPS, SSM_CH)
    lam = lax.complex(jnp.minimum(lam_re.astype(f32), -1e-4), lam_im.astype(f32))
    dt = jnp.exp(log_dt.astype(f32))[:, None]
    a_bar = jnp.exp(lam * dt)
    b = lax.complex(b_re.astype(f32), b_im.astype(f32))
    b_bar = ((a_bar - 1.0) / lam)[..., None] * b
    c = lax.complex(c_re.astype(f32), c_im.astype(f32))
    bu = jnp.einsum('gpc,btgc->btgp', b_bar, ug.astype(jnp.complex64))
    h0c = lax.complex(h0[..., 0].astype(f32), h0[..., 1].astype(f32))
    bu = bu.at[:, 0].add(a_bar[None] * h0c)
    a = jnp.broadcast_to(a_bar, bu.shape)
    _, xs = lax.associative_scan(_linear_recurrence_combine, (a, bu), axis=1)
    y = jnp.einsum('gcp,btgp->btgc', c, xs).real.reshape(B, T, D_SSM) + d_skip.astype(f32) * u
    z = jax.nn.gelu(y).astype(h.dtype)
    ga = z @ w_glu
    out = ga[..., :D_MODEL] * jax.nn.sigmoid(ga[..., D_MODEL:])
    x_last = xs[:, -1]
    new_state = jnp.stack([x_last.real, x_last.imag], axis=-1).astype(h0.dtype)
    return out, new_state


def conv_ffn(h, conv_state, w_up, conv_w, conv_b, w_down):
    T = h.shape[1]
    u = h @ w_up
    up = jnp.concatenate([conv_state.astype(u.dtype), u], axis=1)
    c = conv_b
    for j in range(CONV_WIDTH):
        c = c + conv_w[j] * up[:, j:j + T]
    gate, val = c[..., :D_FF], c[..., D_FF:]
    out = (jax.nn.silu(gate) * val) @ w_down
    return out, up[:, -(CONV_WIDTH - 1):]


def setup_inputs(seed: int = 0) -> dict:
    key = jax.random.key(seed)
    ks = iter(jax.random.split(key, 32))

    def nrm(shape, scale=1.0):
        return scale * jax.random.normal(next(ks), shape, jnp.float32)

    attn_w = HEADS_PER_GROUP * HEAD_DIM
    qkv_cols = 3 * N_DIL * attn_w
    inp = {}
    inp["x_prompt"] = nrm((BATCH, SEQ, D_MODEL))
    inp["x_sample"] = nrm((DEC_BATCH, DEC_SEQ, D_MODEL))
    for g, (win, _) in enumerate(DIL_GROUPS):
        inp["cache_kv_g%d" % g] = nrm((N_ATTN_LAYERS, DEC_BATCH, min(win, PAST_LEN), 2, HEADS_PER_GROUP, HEAD_DIM))
    inp["state_ssm"] = nrm((N_SSM_LAYERS, DEC_BATCH, SSM_GROUPS, SSM_STATE, 2))
    inp["state_conv"] = nrm((DEPTH, DEC_BATCH, CONV_WIDTH - 1, 2 * D_FF))
    inp["norm_g"] = 1.0 + nrm((DEPTH, 4, D_MODEL), 0.05)
    inp["w_qkv"] = nrm((N_ATTN_LAYERS, D_MODEL, qkv_cols), D_MODEL ** -0.5)
    inp["w_attn_o"] = nrm((N_ATTN_LAYERS, attn_w, D_MODEL), attn_w ** -0.5)
    inp["w_ssm_in"] = nrm((N_SSM_LAYERS, D_MODEL, D_SSM), D_MODEL ** -0.5)
    inp["lambda_re"] = -0.5 + nrm((N_SSM_LAYERS, SSM_GROUPS, SSM_STATE), 0.01)
    inp["lambda_im"] = jnp.pi * jnp.arange(SSM_STATE, dtype=jnp.float32) + nrm((N_SSM_LAYERS, SSM_GROUPS, SSM_STATE), 0.01)
    inp["log_dt"] = jax.random.uniform(next(ks), (N_SSM_LAYERS, SSM_GROUPS), jnp.float32, math.log(DT_MIN), math.log(DT_MAX))
    inp["b_re"] = nrm((N_SSM_LAYERS, SSM_GROUPS, SSM_STATE, SSM_CH), (2 * SSM_CH) ** -0.5)
    inp["b_im"] = nrm((N_SSM_LAYERS, SSM_GROUPS, SSM_STATE, SSM_CH), (2 * SSM_CH) ** -0.5)
    inp["c_re"] = nrm((N_SSM_LAYERS, SSM_GROUPS, SSM_CH, SSM_STATE), (2 * SSM_STATE) ** -0.5)
    inp["c_im"] = nrm((N_SSM_LAYERS, SSM_GROUPS, SSM_CH, SSM_STATE), (2 * SSM_STATE) ** -0.5)
    inp["d_skip"] = nrm((N_SSM_LAYERS, D_SSM))
    inp["w_glu"] = nrm((N_SSM_LAYERS, D_SSM, 2 * D_MODEL), D_SSM ** -0.5)
    inp["w_up"] = nrm((DEPTH, D_MODEL, 2 * D_FF), D_MODEL ** -0.5)
    inp["conv_w"] = nrm((DEPTH, CONV_WIDTH, 2 * D_FF), CONV_WIDTH ** -0.5)
    inp["conv_b"] = nrm((DEPTH, 2 * D_FF), 0.01)
    inp["w_down"] = nrm((DEPTH, D_FF, D_MODEL), D_FF ** -0.5)
    return inp


def reference(x_prompt, x_sample, cache_kv_g0, cache_kv_g1, cache_kv_g2, state_ssm, state_conv,
              norm_g, w_qkv, w_attn_o, w_ssm_in, lambda_re, lambda_im, log_dt, b_re, b_im, c_re, c_im,
              d_skip, w_glu, w_up, conv_w, conv_b, w_down):
    xp, xs = x_prompt, x_sample
    Bp = xp.shape[0]
    kv_p = [[] for _ in range(N_DIL)]
    kv_s = [[] for _ in range(N_DIL)]
    ssm_p, ssm_s, conv_p, conv_s = [], [], [], []
    for i in range(DEPTH):
        li = i // N_MIXERS
        hp = rms_norm(xp, norm_g[i, 0])
        hs = rms_norm(xs, norm_g[i, 0])
        if i % N_MIXERS == 0:
            mp, new_p = attn_prompt(hp, w_qkv[li], w_attn_o[li])
            ms, new_s = attn_sample(hs, (cache_kv_g0[li], cache_kv_g1[li], cache_kv_g2[li]), w_qkv[li], w_attn_o[li])
            for g in range(N_DIL):
                kv_p[g].append(new_p[g])
                kv_s[g].append(new_s[g])
        else:
            prm = (w_ssm_in[li], lambda_re[li], lambda_im[li], log_dt[li], b_re[li], b_im[li],
                   c_re[li], c_im[li], d_skip[li], w_glu[li])
            h0_p = jnp.zeros((Bp, SSM_GROUPS, SSM_STATE, 2), state_ssm.dtype)
            mp, sp = s5_mixer(hp, h0_p, *prm)
            ms, ss = s5_mixer(hs, state_ssm[li], *prm)
            ssm_p.append(sp)
            ssm_s.append(ss)
        xp = xp + rms_norm(mp, norm_g[i, 1])
        xs = xs + rms_norm(ms, norm_g[i, 1])
        hp = rms_norm(xp, norm_g[i, 2])
        hs = rms_norm(xs, norm_g[i, 2])
        c0_p = jnp.zeros((Bp, CONV_WIDTH - 1, 2 * D_FF), state_conv.dtype)
        fp, cp = conv_ffn(hp, c0_p, w_up[i], conv_w[i], conv_b[i], w_down[i])
        fs, cs = conv_ffn(hs, state_conv[i], w_up[i], conv_w[i], conv_b[i], w_down[i])
        conv_p.append(cp)
        conv_s.append(cs)
        xp = xp + rms_norm(fp, norm_g[i, 3])
        xs = xs + rms_norm(fs, norm_g[i, 3])
    y_prompt, y_sample = xp, xs
    return (y_prompt, y_sample,
            jnp.stack(kv_p[0]), jnp.stack(kv_s[0]),
            jnp.stack(kv_p[1]), jnp.stack(kv_s[1]),
            jnp.stack(kv_p[2]), jnp.stack(kv_s[2]),
            jnp.stack(ssm_p), jnp.stack(ssm_s),
            jnp.stack(conv_p), jnp.stack(conv_s))
```

```cpp
#include <hip/hip_runtime.h>
#include <cstdio>
#include <cstdint>

constexpr int NWAVES = 8;
constexpr int NB = 4, T = 2048, D = 2048, MP = NB * T, NS = 8;
constexpr int NQKV = 9216, AW = 1024, FF = 5504, FF2 = 11008, GLU2 = 4096;
constexpr float RMS_EPS = 1e-6f;
constexpr int N_PHASES = 35;

constexpr size_t O_YP = 0;
constexpr size_t O_YS = O_YP + (size_t)MP * D;
constexpr size_t KV0P_L = (size_t)4 * 128 * 2048, KV1P_L = (size_t)4 * 512 * 2048, KV2P_L = (size_t)4 * 2048 * 2048, KVS_L = 8 * 2048;
constexpr size_t O_KV0P = O_YS + (size_t)NS * D;
constexpr size_t O_KV0S = O_KV0P + 2 * KV0P_L;
constexpr size_t O_KV1P = O_KV0S + 2 * KVS_L;
constexpr size_t O_KV1S = O_KV1P + 2 * KV1P_L;
constexpr size_t O_KV2P = O_KV1S + 2 * KVS_L;
constexpr size_t O_KV2S = O_KV2P + 2 * KV2P_L;
constexpr size_t O_SSMP = O_KV2S + 2 * KVS_L;
constexpr size_t SSMP_L = 4 * 128 * 64 * 2, SSMS_L = 8 * 128 * 64 * 2;
constexpr size_t O_SSMS = O_SSMP + 2 * SSMP_L;
constexpr size_t O_CONVP = O_SSMS + 2 * SSMS_L;
constexpr size_t CONVP_L = 4 * 2 * FF2, CONVS_L = 8 * 2 * FF2;
constexpr size_t O_CONVS = O_CONVP + 4 * CONVP_L;
constexpr size_t O_END = O_CONVS + 4 * CONVS_L;
static_assert(O_END == 62382080, "d_out layout");

namespace pg8 {
#define PG8_LAS __attribute__((address_space(3)))
typedef unsigned short bf16_t;
typedef short bf16x8 __attribute__((ext_vector_type(8)));
typedef float f32x4 __attribute__((ext_vector_type(4)));
typedef unsigned u32x4 __attribute__((ext_vector_type(4)));
constexpr int BM = 256, BK = 64, HALF = 128, HTB = HALF * BK * 2  , STAGE_BYTES = 8 * HTB, NXCD = 8, WGM = 8;

__host__ __device__ __forceinline__ int lds_byte(int r, int c) { const int st = (r >> 4) * 2 + (c >> 5), rr = r & 15, cc = c & 31, ob = rr * 64 + cc * 2; return st * 1024 + (ob ^ (((ob >> 9) & 1) << 5)); }
__host__ __device__ __forceinline__ void stage_rc(int b, int& R, int& C) { const int st = b / 1024, sb = b % 1024, swz = sb ^ (((sb >> 9) & 1) << 5); R = (st >> 1) * 16 + swz / 64; C = (st & 1) * 32 + (swz % 64) / 2; }
__host__ __device__ __forceinline__ int perm32(int rho) { const int n = rho >> 4, i = rho & 15; return 8 * (i >> 2) + 4 * n + (i & 3); }

struct Unit { int pm, pn; };
struct Gemm { const bf16_t* A; const bf16_t* Bt; int M, N, K; };

struct StaticOrder {
    int nM, nN, nwg, G, c;
    __host__ __device__ void init(int M, int N, int G_, int c_) { nM = M / BM; nN = N / BM; nwg = nM * nN; G = G_; c = c_; }
    __host__ __device__ bool next(int i, Unit& u) const {
        const long L = (long)i * G + c; if (L >= nwg) return false;
        int wgid = (int)L; { const int q = nwg / NXCD, r = nwg % NXCD, xcd = wgid % NXCD, off = wgid / NXCD; wgid = (xcd < r ? xcd * (q + 1) : r * (q + 1) + (xcd - r) * q) + off; }
        const int nig = WGM * nN, gid = wgid / nig, fm = gid * WGM, gsz = (nM - fm) < WGM ? (nM - fm) : WGM;
        u.pm = fm + ((wgid % nig) % gsz); u.pn = (wgid % nig) / gsz; return true;
    }
    __device__ __forceinline__ void a_ready(const Unit&) const {}
    __device__ __forceinline__ void done(const Unit&) const {}
};


__device__ __forceinline__ unsigned cvt_pk_bf16(float lo, float hi) { unsigned r; asm volatile("v_cvt_pk_bf16_f32 %0, %1, %2" : "=v"(r) : "v"(lo), "v"(hi)); return r; }
typedef unsigned u32x2 __attribute__((ext_vector_type(2)));

struct EpiF32 {
    static constexpr bool PERM = false, AFTER_DRAIN = false;
    float* C; int ldc;
    __device__ __forceinline__ void operator()(const f32x4 (&acc)[2][2][4][2], const Unit& u, int wr, int wc, int fr, int fq) const {
        const int row0 = u.pm * BM + wr * 64 + fr, col0 = u.pn * BM + wc * 32 + 4 * fq;
#pragma unroll
        for (int ai = 0; ai < 2; ++ai)
#pragma unroll
            for (int m = 0; m < 4; ++m) { float* rowp = C + (size_t)(row0 + ai * HALF + m * 16) * ldc + col0;
#pragma unroll
                for (int bj = 0; bj < 2; ++bj)
#pragma unroll
                    for (int n = 0; n < 2; ++n) *(f32x4*)(rowp + bj * HALF + n * 16) = acc[ai][bj][m][n]; }
    }
};
struct EpiBf16 {
    static constexpr bool PERM = true, AFTER_DRAIN = false;
    bf16_t* O; int ldc;
    __device__ __forceinline__ void operator()(const f32x4 (&acc)[2][2][4][2], const Unit& u, int wr, int wc, int fr, int fq) const {
        const int row0 = u.pm * BM + wr * 64 + fr, col0 = u.pn * BM + wc * 32 + 8 * fq;
#pragma unroll
        for (int ai = 0; ai < 2; ++ai)
#pragma unroll
            for (int m = 0; m < 4; ++m) { bf16_t* rowp = O + (size_t)(row0 + ai * HALF + m * 16) * ldc + col0;
#pragma unroll
                for (int bj = 0; bj < 2; ++bj) { const f32x4 v0 = acc[ai][bj][m][0], v1 = acc[ai][bj][m][1];
                    u32x4 w; w.x = cvt_pk_bf16(v0[0], v0[1]); w.y = cvt_pk_bf16(v0[2], v0[3]); w.z = cvt_pk_bf16(v1[0], v1[1]); w.w = cvt_pk_bf16(v1[2], v1[3]);
                    *(u32x4*)(rowp + bj * HALF) = w; } }
    }
};
struct EpiGLU {
    static constexpr bool PERM = true, AFTER_DRAIN = false;
    bf16_t* C;
    __device__ __forceinline__ void operator()(const f32x4 (&acc)[2][2][4][2], const Unit& u, int wr, int wc, int fr, int fq) const {
        const int row0 = u.pm * BM + wr * 64 + fr, col0 = u.pn * HALF + wc * 32 + 8 * fq;
#pragma unroll
        for (int ai = 0; ai < 2; ++ai)
#pragma unroll
            for (int m = 0; m < 4; ++m) { bf16_t* rowp = C + (size_t)(row0 + ai * HALF + m * 16) * 2048 + col0; u32x4 w;
#pragma unroll
                for (int n = 0; n < 2; ++n) { const f32x4 a = acc[ai][0][m][n], g = acc[ai][1][m][n]; f32x4 o;
#pragma unroll
                    for (int e = 0; e < 4; ++e) o[e] = a[e] * __builtin_amdgcn_rcpf(1.0f + __builtin_amdgcn_exp2f(-1.44269504089f * g[e]));
                    if (n == 0) { w.x = cvt_pk_bf16(o[0], o[1]); w.y = cvt_pk_bf16(o[2], o[3]); } else { w.z = cvt_pk_bf16(o[0], o[1]); w.w = cvt_pk_bf16(o[2], o[3]); } }
                *(u32x4*)rowp = w; }
    }
};
struct EpiQKV {
    static constexpr bool PERM = true, AFTER_DRAIN = false;
    bf16_t* Q; bf16_t* VT; const float* cs; float* out; int li; float qscale;
    __device__ __forceinline__ void operator()(const f32x4 (&acc)[2][2][4][2], const Unit& u, int wr, int wc, int fr, int fq) const {
        const int which = u.pn / 12, rem = u.pn - which * 12, g = rem >> 2, hp = rem & 3;
        const int dsh = 2 * g, S = 2048 >> dsh, keep = 128 << dsh;
        const size_t kvoff = g == 0 ? (O_KV0P + (size_t)li * KV0P_L) : (g == 1 ? (O_KV1P + (size_t)li * KV1P_L) : (O_KV2P + (size_t)li * KV2P_L));
        float* kvout = out + kvoff;
        const int d0 = wc * 32 + 8 * fq;
        const bool rot = (which < 2) && (wc == 0);
        const bool hi = fq >= 2;
#pragma unroll
        for (int ai = 0; ai < 2; ++ai)
#pragma unroll
            for (int m = 0; m < 4; ++m) {
                const int row = u.pm * BM + ai * HALF + wr * 64 + m * 16 + fr;
                const int b = row >> 11, t = row & 2047;
                const int idx = (t & ((1 << dsh) - 1)) * S + (t >> dsh);
                f32x4 c0 = (f32x4){1.f, 1.f, 1.f, 1.f}, c1 = c0, s0 = (f32x4){0.f, 0.f, 0.f, 0.f}, s1 = s0;
                if (rot) { const float* cp = cs + t * 32 + 8 * (fq & 1); c0 = *(const f32x4*)cp; c1 = *(const f32x4*)(cp + 4); s0 = *(const f32x4*)(cp + 16); s1 = *(const f32x4*)(cp + 20); }
#pragma unroll
                for (int bj = 0; bj < 2; ++bj) {
                    const int h = 2 * hp + bj, bgh = (b * 3 + g) * 8 + h;
                    f32x4 v0 = acc[ai][bj][m][0], v1 = acc[ai][bj][m][1];
                    if (rot) {
                        f32x4 p0, p1;
#pragma unroll
                        for (int e = 0; e < 4; ++e) { p0[e] = __shfl_xor(v0[e], 32); p1[e] = __shfl_xor(v1[e], 32); }
                        if (hi) { v0 = v0 * c0 + p0 * s0; v1 = v1 * c1 + p1 * s1; } else { v0 = v0 * c0 - p0 * s0; v1 = v1 * c1 - p1 * s1; }
                    }
                    if (which >= 1) { const int tt = t - (2048 - keep);
                        if (tt >= 0) { float* o = kvout + ((((size_t)b * keep + tt) * 2 + (which - 1)) * 8 + h) * 128 + d0; *(f32x4*)o = v0; *(f32x4*)(o + 4) = v1; } }
                    if (which == 0) { v0 = v0 * qscale; v1 = v1 * qscale; }
                    bf16_t* o = Q + (size_t)which * ((size_t)48 << 19) + ((size_t)bgh * 2048 + idx) * 128 + d0;
                    u32x4 w; w.x = cvt_pk_bf16(v0[0], v0[1]); w.y = cvt_pk_bf16(v0[2], v0[3]); w.z = cvt_pk_bf16(v1[0], v1[1]); w.w = cvt_pk_bf16(v1[2], v1[3]);
                    *(u32x4*)o = w;
                }
            }
    }
};
__device__ __forceinline__ float dpp_shr1(float cur, float prevgrp) {
    const int x = __builtin_amdgcn_update_dpp(0, __float_as_int(prevgrp), 0x121, 0xF, 0xF, false);
    return __int_as_float(__builtin_amdgcn_update_dpp(x, __float_as_int(cur), 0x111, 0xF, 0xF, false)); }
__device__ __forceinline__ float dpp_shr2(float cur, float prevgrp) {
    const int x = __builtin_amdgcn_update_dpp(0, __float_as_int(prevgrp), 0x122, 0xF, 0xF, false);
    return __int_as_float(__builtin_amdgcn_update_dpp(x, __float_as_int(cur), 0x112, 0xF, 0xF, false)); }
struct EpiConv {
    static constexpr bool PERM = true, AFTER_DRAIN = false;
    bf16_t* ACT; const float* cw; const float* cb; float* part; float* halou; float* convp; PG8_LAS float* halo;
    __device__ __forceinline__ void operator()(const f32x4 (&acc)[2][2][4][2], const Unit& u, int wr, int wc, int fr, int fq) const {
        constexpr int FFc = 5504, FF2c = 11008;
        if (fr >= 14) {
#pragma unroll
            for (int ai = 0; ai < 2; ++ai)
#pragma unroll
                for (int bj = 0; bj < 2; ++bj)
#pragma unroll
                    for (int n = 0; n < 2; ++n) *(PG8_LAS f32x4*)(halo + ((((ai * 2 + wr) * 4 + wc) * 2 + (fr - 14)) * 64 + bj * 32 + 8 * fq + 4 * n)) = acc[ai][bj][3][n];
            if (wr == 1) {
#pragma unroll
                for (int bj = 0; bj < 2; ++bj)
#pragma unroll
                    for (int n = 0; n < 2; ++n) { const int cs_ = bj * HALF + wc * 32 + 8 * fq + 4 * n;
                        *(f32x4*)(halou + ((size_t)u.pm * 2 + (fr - 14)) * FF2c + u.pn * BM + cs_) = acc[1][bj][3][n];
                        if ((u.pm & 7) == 7) *(f32x4*)(convp + ((size_t)(u.pm >> 3) * 2 + (fr - 14)) * FF2c + bj * FFc + u.pn * HALF + wc * 32 + 8 * fq + 4 * n) = acc[1][bj][3][n]; }
            }
        }
        asm volatile("s_waitcnt lgkmcnt(0)" ::: "memory"); __builtin_amdgcn_s_barrier(); asm volatile("" ::: "memory");
        const bool seq_start = (u.pm & 7) == 0;
        u32x2 keep[2][4];
#pragma unroll
        for (int n = 0; n < 2; ++n) {
            const int jg = u.pn * HALF + wc * 32 + 8 * fq + 4 * n;
            const f32x4 bg = *(const f32x4*)(cb + jg), bv = *(const f32x4*)(cb + FFc + jg);
            const f32x4 g0w = *(const f32x4*)(cw + jg), g1w = *(const f32x4*)(cw + FF2c + jg), g2w = *(const f32x4*)(cw + 2 * FF2c + jg);
            const f32x4 v0w = *(const f32x4*)(cw + FFc + jg), v1w = *(const f32x4*)(cw + FF2c + FFc + jg), v2w = *(const f32x4*)(cw + 2 * FF2c + FFc + jg);
#pragma unroll
            for (int ai = 0; ai < 2; ++ai)
#pragma unroll
                for (int m = 0; m < 4; ++m) {
                    const f32x4 cg = acc[ai][0][m][n], cv = acc[ai][1][m][n];
                    f32x4 pg = (f32x4){0.f, 0.f, 0.f, 0.f}, pv = (f32x4){0.f, 0.f, 0.f, 0.f};
                    if (m > 0) { pg = acc[ai][0][m - 1][n]; pv = acc[ai][1][m - 1][n]; }
                    else if (!(ai == 0 && wr == 0)) { const int pai = wr == 1 ? ai : ai - 1, pwr = wr == 1 ? 0 : 1;
                        if (fr >= 14) { const PG8_LAS float* hp = halo + ((((pai * 2 + pwr) * 4 + wc) * 2 + (fr - 14)) * 64 + 8 * fq + 4 * n); pg = *(const PG8_LAS f32x4*)hp; pv = *(const PG8_LAS f32x4*)(hp + 32); } }
                    f32x4 og, ov;
#pragma unroll
                    for (int e = 0; e < 4; ++e) {
                        const float g1 = dpp_shr1(cg[e], pg[e]), g2 = dpp_shr2(cg[e], pg[e]), v1 = dpp_shr1(cv[e], pv[e]), v2 = dpp_shr2(cv[e], pv[e]);
                        og[e] = bg[e] + g0w[e] * g2 + g1w[e] * g1 + g2w[e] * cg[e]; ov[e] = bv[e] + v0w[e] * v2 + v1w[e] * v1 + v2w[e] * cv[e]; }
                    const int row = u.pm * BM + ai * HALF + wr * 64 + m * 16 + fr;
                    const bool partial = (ai == 0 && wr == 0 && m == 0 && fr < 2 && !seq_start);
                    if (partial) { float* pp = part + ((size_t)u.pm * 2 + fr) * FF2c + u.pn * BM + wc * 32 + 8 * fq + 4 * n; *(f32x4*)pp = og; *(f32x4*)(pp + HALF) = ov; }
                    f32x4 a;
#pragma unroll
                    for (int e = 0; e < 4; ++e) a[e] = og[e] * __builtin_amdgcn_rcpf(1.0f + __builtin_amdgcn_exp2f(-1.44269504089f * og[e])) * ov[e];
                    u32x2 w; w.x = cvt_pk_bf16(a[0], a[1]); w.y = cvt_pk_bf16(a[2], a[3]);
                    if (n == 0) keep[ai][m] = w;
                    else if (!partial) { u32x4 w4; w4.x = keep[ai][m].x; w4.y = keep[ai][m].y; w4.z = w.x; w4.w = w.y; *(u32x4*)(ACT + (size_t)row * FFc + jg - 4) = w4; }
                }
        }
    }
};

template <class Epi, class Sched, bool ALIGN_EPI = false, bool SP2 = false>
__device__ __forceinline__ void gemm_phase(PG8_LAS unsigned char* lds, const Gemm g, const Sched& S, const Epi& E) {
    const int tid = threadIdx.x, wid = __builtin_amdgcn_readfirstlane(tid >> 6), lane = tid & 63, wr = wid >> 2, wc = wid & 3, fr = lane & 15, fq = lane >> 4;
    const int K = g.K, nt = K / BK;
    unsigned voffA[2], voffB[2];
#pragma unroll
    for (int i = 0; i < 2; ++i) { int R, C; stage_rc(tid * 16 + i * 8192, R, C); const int Rb = Epi::PERM ? ((R & ~31) + perm32(R & 31)) : R;
        voffA[i] = (unsigned)(R * K + C) * 2u; voffB[i] = (unsigned)(Rb * K + C) * 2u; }
    const size_t kstep = (size_t)(BK * 2);
    const size_t hstep = (size_t)HALF * K * 2;
    const size_t tstep = 2 * hstep;
    const unsigned ldsw = (unsigned)wid * 1024u;
    const int aoff = lds_byte(wr * 64 + fr, fq * 8), boff = lds_byte(wc * 32 + fr, fq * 8);
#define PG8_SA(b, h) (((b) * 2 + (h)) * HTB)
#define PG8_SB(b, h) ((4 + (b) * 2 + (h)) * HTB)
#define PG8_STAGE(bufoff, gbase, voff) do { _Pragma("unroll") for (int _i = 0; _i < 2; ++_i) \
        __builtin_amdgcn_global_load_lds((const unsigned*)((const char*)(gbase) + (voff)[_i]), (PG8_LAS unsigned*)(lds + (bufoff) + ldsw + _i * 8192), 16, 0, 0); } while (0)
#define PG8_LDA(dst, b, h) do { _Pragma("unroll") for (int m = 0; m < 4; ++m) _Pragma("unroll") for (int k = 0; k < 2; ++k) dst[m][k] = *(const PG8_LAS bf16x8*)(lds + PG8_SA(b, h) + aoff + m * 2048 + k * 1024); } while (0)
#define PG8_LDB(dst, b, h) do { _Pragma("unroll") for (int n = 0; n < 2; ++n) _Pragma("unroll") for (int k = 0; k < 2; ++k) dst[n][k] = *(const PG8_LAS bf16x8*)(lds + PG8_SB(b, h) + boff + n * 2048 + k * 1024); } while (0)
#define PG8_MMA(ai, bj, At, Bt) do { __builtin_amdgcn_s_setprio(1); _Pragma("unroll") for (int m = 0; m < 4; ++m) _Pragma("unroll") for (int n = 0; n < 2; ++n) _Pragma("unroll") for (int k = 0; k < 2; ++k) \
        acc[ai][bj][m][n] = __builtin_amdgcn_mfma_f32_16x16x32_bf16(Bt[n][k], At[m][k], acc[ai][bj][m][n], 0, 0, 0); __builtin_amdgcn_s_setprio(0); } while (0)
#define PG8_WAIT_V(n) asm volatile("s_waitcnt vmcnt(" #n ")" ::: "memory")
#define PG8_WAIT_L(n) asm volatile("s_waitcnt lgkmcnt(" #n ")" ::: "memory")
#define PG8_BAR __builtin_amdgcn_s_barrier()
#define PG8_SCHED __builtin_amdgcn_sched_barrier(0)
    Unit cur, nxt; int ui = 0;
    if (!S.next(0, cur)) return;
    f32x4 acc[2][2][4][2];
#pragma unroll
    for (int a = 0; a < 2; ++a)
#pragma unroll
        for (int b = 0; b < 2; ++b)
#pragma unroll
            for (int m = 0; m < 4; ++m)
#pragma unroll
                for (int n = 0; n < 2; ++n) acc[a][b][m][n] = (f32x4){0.f, 0.f, 0.f, 0.f};
    bf16x8 At[4][2], B0[2][2], B1[2][2];
    const char* cA = (const char*)g.A + (size_t)cur.pm * tstep; const char* cB = (const char*)g.Bt + (size_t)cur.pn * tstep;
    S.a_ready(cur);
    if constexpr (SP2) {
        PG8_STAGE(PG8_SB(0, 0), cB, voffB); PG8_STAGE(PG8_SB(0, 1), cB + hstep, voffB); PG8_STAGE(PG8_SA(0, 0), cA, voffA); PG8_STAGE(PG8_SA(0, 1), cA + hstep, voffA);
        if (wr == 1) PG8_BAR;
        PG8_WAIT_V(2); PG8_BAR;
        PG8_STAGE(PG8_SB(1, 0), cB + kstep, voffB); PG8_STAGE(PG8_SA(1, 0), cA + kstep, voffA); PG8_STAGE(PG8_SB(1, 1), cB + hstep + kstep, voffB);
        PG8_WAIT_V(6); PG8_BAR;
    } else {
        PG8_STAGE(PG8_SB(0, 0), cB, voffB); PG8_STAGE(PG8_SA(0, 0), cA, voffA); PG8_STAGE(PG8_SB(0, 1), cB + hstep, voffB); PG8_STAGE(PG8_SA(0, 1), cA + hstep, voffA);
        if (wr == 1) PG8_BAR;
        PG8_WAIT_V(4); PG8_BAR;
        PG8_STAGE(PG8_SB(1, 0), cB + kstep, voffB); PG8_STAGE(PG8_SA(1, 0), cA + kstep, voffA); PG8_STAGE(PG8_SB(1, 1), cB + hstep + kstep, voffB);
        PG8_WAIT_V(6); PG8_BAR;
    }
    for (;;) {
        const bool has_next = S.next(ui + 1, nxt);
        const char* nA = has_next ? (const char*)g.A + (size_t)nxt.pm * tstep : cA; const char* nB = has_next ? (const char*)g.Bt + (size_t)nxt.pn * tstep : cB;
        for (int t = 0; t < nt; t += 2) {
            const bool last = (t == nt - 2);
            const char* a1 = cA + (size_t)(t + 1) * kstep;
            const char* a2 = last ? nA : cA + (size_t)(t + 2) * kstep; const char* b2 = last ? nB : cB + (size_t)(t + 2) * kstep;
            const char* a3 = a2 + kstep; const char* b3 = b2 + kstep;
            if (last && has_next) S.a_ready(nxt);
            if constexpr (SP2) {
            PG8_LDB(B0, 0, 0); PG8_LDB(B1, 0, 1); PG8_SCHED; PG8_LDA(At, 0, 0); PG8_STAGE(PG8_SA(1, 1), a1 + hstep, voffA);
            PG8_WAIT_V(8); PG8_WAIT_L(0); PG8_BAR; PG8_MMA(0, 0, At, B0); PG8_MMA(0, 1, At, B1); PG8_BAR; PG8_SCHED;
            PG8_LDA(At, 0, 1); PG8_STAGE(PG8_SB(0, 0), b2, voffB); PG8_STAGE(PG8_SB(0, 1), b2 + hstep, voffB); PG8_STAGE(PG8_SA(0, 0), a2, voffA);
            PG8_WAIT_V(8); PG8_WAIT_L(0); PG8_BAR; PG8_MMA(1, 0, At, B0); PG8_MMA(1, 1, At, B1); PG8_BAR; PG8_SCHED;
            PG8_LDB(B0, 1, 0); PG8_LDB(B1, 1, 1); PG8_SCHED; PG8_LDA(At, 1, 0); PG8_STAGE(PG8_SA(0, 1), a2 + hstep, voffA);
            PG8_WAIT_V(8); PG8_WAIT_L(0); PG8_BAR; PG8_MMA(0, 0, At, B0); PG8_MMA(0, 1, At, B1); PG8_BAR; PG8_SCHED;
            PG8_LDA(At, 1, 1); PG8_STAGE(PG8_SB(1, 0), b3, voffB); PG8_STAGE(PG8_SB(1, 1), b3 + hstep, voffB); PG8_STAGE(PG8_SA(1, 0), a3, voffA);
            PG8_WAIT_V(8); PG8_WAIT_L(0); PG8_BAR; PG8_MMA(1, 0, At, B0); PG8_MMA(1, 1, At, B1); PG8_BAR; PG8_SCHED;
            } else {
            PG8_LDB(B0, 0, 0); PG8_SCHED; PG8_LDA(At, 0, 0); PG8_STAGE(PG8_SA(1, 1), a1 + hstep, voffA);
            PG8_WAIT_L(8); PG8_BAR; PG8_WAIT_L(0); PG8_MMA(0, 0, At, B0); PG8_BAR; PG8_SCHED;
            PG8_LDB(B1, 0, 1); PG8_STAGE(PG8_SB(0, 0), b2, voffB);
            PG8_BAR; PG8_WAIT_L(0); PG8_MMA(0, 1, At, B1); PG8_BAR;
            PG8_LDA(At, 0, 1); PG8_STAGE(PG8_SA(0, 0), a2, voffA);
            PG8_BAR; PG8_WAIT_L(0); PG8_MMA(1, 0, At, B0); PG8_BAR; PG8_SCHED;
            PG8_STAGE(PG8_SB(0, 1), b2 + hstep, voffB);
            PG8_WAIT_V(6); PG8_BAR; PG8_MMA(1, 1, At, B1); PG8_BAR;
            PG8_LDB(B0, 1, 0); PG8_SCHED; PG8_LDA(At, 1, 0); PG8_STAGE(PG8_SA(0, 1), a2 + hstep, voffA);
            PG8_WAIT_L(8); PG8_BAR; PG8_WAIT_L(0); PG8_MMA(0, 0, At, B0); PG8_BAR; PG8_SCHED;
            PG8_LDB(B1, 1, 1); PG8_STAGE(PG8_SB(1, 0), b3, voffB);
            PG8_BAR; PG8_WAIT_L(0); PG8_MMA(0, 1, At, B1); PG8_BAR;
            PG8_LDA(At, 1, 1); PG8_STAGE(PG8_SA(1, 0), a3, voffA);
            PG8_BAR; PG8_WAIT_L(0); PG8_MMA(1, 0, At, B0); PG8_BAR; PG8_SCHED;
            PG8_STAGE(PG8_SB(1, 1), b3 + hstep, voffB);
            PG8_WAIT_V(6); PG8_BAR; PG8_MMA(1, 1, At, B1); PG8_BAR;
            }
        }
        if constexpr (ALIGN_EPI) { if (wr == 0) PG8_BAR; }
        if constexpr (!Epi::AFTER_DRAIN) { E(acc, cur, wr, wc, fr, fq); S.done(cur); }
        if (!has_next) break;
#pragma unroll
        for (int a = 0; a < 2; ++a)
#pragma unroll
            for (int b = 0; b < 2; ++b)
#pragma unroll
                for (int m = 0; m < 4; ++m)
#pragma unroll
                    for (int n = 0; n < 2; ++n) acc[a][b][m][n] = (f32x4){0.f, 0.f, 0.f, 0.f};
        cur = nxt; cA = nA; cB = nB; ++ui;
        if constexpr (ALIGN_EPI) { if (wr == 1) PG8_BAR; }
    }
    PG8_WAIT_V(0);
    if constexpr (!ALIGN_EPI) { if (wr == 0) PG8_BAR; }
    PG8_BAR;
    if constexpr (Epi::AFTER_DRAIN) { E.fused(acc, cur, wr, wc, fr, fq, lds, wid, lane); S.done(cur); }
#undef PG8_SA
#undef PG8_SB
#undef PG8_STAGE
#undef PG8_LDA
#undef PG8_LDB
#undef PG8_MMA
#undef PG8_WAIT_V
#undef PG8_WAIT_L
#undef PG8_BAR
#undef PG8_SCHED
}

}

constexpr size_t MiB = 1u << 20;
constexpr size_t WS_CTL = 0, CTL_ZERO_BYTES = 1 * MiB;
constexpr size_t WS_CS = 1 * MiB;
constexpr size_t WS_SMP = 2 * MiB;
constexpr size_t WS_WQKV = 4 * MiB,  WQKV_L = (size_t)NQKV * D * 2;
constexpr size_t WS_WO = 76 * MiB,   WO_L = (size_t)D * AW * 2;
constexpr size_t WS_WIN = 84 * MiB,  WIN_L = (size_t)D * D * 2;
constexpr size_t WS_WGLU = 100 * MiB, WGLU_L = (size_t)GLU2 * D * 2;
constexpr size_t WS_WUP = 132 * MiB, WUP_L = (size_t)FF2 * D * 2;
constexpr size_t WS_WDN = 304 * MiB, WDN_L = (size_t)D * FF * 2;
constexpr size_t WS_H = 390 * MiB;
constexpr size_t WS_Q = 422 * MiB, WS_K = 470 * MiB, WS_VT = 518 * MiB;
constexpr size_t WS_OG = 566 * MiB;
constexpr size_t WS_LSE = 614 * MiB;
constexpr size_t WS_O = 615 * MiB;
constexpr size_t WS_M = 631 * MiB;
constexpr size_t WS_U = 695 * MiB;
constexpr size_t WS_ACT = 867 * MiB;
constexpr size_t WS_USSM = 953 * MiB;
constexpr size_t WS_Z = 985 * MiB;
constexpr size_t WS_LL = 1017 * MiB;
constexpr size_t WS_END = 1018 * MiB;
static_assert(WS_WQKV + 2 * WQKV_L <= WS_WO && WS_WO + 2 * WO_L <= WS_WIN && WS_WIN + 2 * WIN_L <= WS_WGLU && WS_WGLU + 2 * WGLU_L <= WS_WUP && WS_WUP + 4 * WUP_L <= WS_WDN && WS_WDN + 4 * WDN_L <= WS_H, "ws map (weights)");
static_assert(WS_U + (size_t)MP * FF2 * 2 <= WS_ACT && WS_ACT + (size_t)MP * FF * 2 <= WS_USSM, "ws map (acts)");
constexpr size_t SM_HS = 0;
constexpr size_t SM_QKV = 64 * 1024;
constexpr size_t SM_OSG = 384 * 1024;
constexpr size_t SM_LSE = 512 * 1024;
constexpr size_t SM_OS = 528 * 1024;
constexpr size_t SM_MS = 576 * 1024;
constexpr size_t SM_US = 704 * 1024;
constexpr size_t SM_ACT = 1088 * 1024;
constexpr size_t SM_ZS = 1216 * 1024;
constexpr size_t SM_USSM = 1280 * 1024;
constexpr int CW_BAR = 4096;
constexpr int CW_CONVQ = 12288;

constexpr int RING_BYTES = 131072;
constexpr int LDS_BYTES = 163840;
constexpr int MISC_OFF = LDS_BYTES - 256;

#ifndef CONV_TAILS
#define CONV_TAILS 1
#endif
#ifndef CONV_NQ
#define CONV_NQ 8
#endif
#ifndef CONV_NU
#define CONV_NU 7
#endif
#ifndef CONV_KT
#define CONV_KT 64
#endif
#define LAS __attribute__((address_space(3)))
typedef unsigned short bf16;
typedef float f32x4 __attribute__((ext_vector_type(4)));
typedef float f32x2 __attribute__((ext_vector_type(2)));
typedef short bf16x8 __attribute__((ext_vector_type(8)));
typedef short bf16x4 __attribute__((ext_vector_type(4)));
typedef unsigned u32x4 __attribute__((ext_vector_type(4)));
typedef unsigned u32x2 __attribute__((ext_vector_type(2)));
#define LDS_WAIT() asm volatile("s_waitcnt lgkmcnt(0)" ::: "memory")
__device__ __forceinline__ unsigned pk2(float lo, float hi) { return pg8::cvt_pk_bf16(lo, hi); }
typedef __bf16 bf16v2 __attribute__((ext_vector_type(2)));
__device__ __forceinline__ unsigned pk2v(float lo, float hi) { return __builtin_bit_cast(unsigned, __builtin_convertvector((f32x2){lo, hi}, bf16v2)); }
__device__ __forceinline__ float bf2f(unsigned short b) { return __uint_as_float(((unsigned)b) << 16); }
__device__ __forceinline__ float bflo(unsigned w) { return __uint_as_float(w << 16); }
__device__ __forceinline__ float bfhi(unsigned w) { return __uint_as_float(w & 0xffff0000u); }
__device__ __forceinline__ float wave_sum(float v) {
#pragma unroll
    for (int o = 1; o < 64; o <<= 1) v += __shfl_xor(v, o);
    return v;
}
__device__ __forceinline__ float sigmoidf_(float x) { return __builtin_amdgcn_rcpf(1.0f + __builtin_amdgcn_exp2f(-1.44269504089f * x)); }
__device__ __forceinline__ float gelu_tanh(float y) { const float z = 0.7978845608028654f * (y + 0.044715f * y * y * y); return y * sigmoidf_(2.0f * z); }
__device__ __forceinline__ void sincos_rr(float ang, float& s, float& c) {
    const double x = (double)ang, kd = rint(x * 0.63661977236758134308), r = fma(-kd, 1.57079632679489661923, x) - kd * 6.123233995736766e-17, r2 = r * r;
    double sp = 1.0 / 6227020800.0; sp = sp * r2 - 1.0 / 39916800.0; sp = sp * r2 + 1.0 / 362880.0; sp = sp * r2 - 1.0 / 5040.0; sp = sp * r2 + 1.0 / 120.0; sp = sp * r2 - 1.0 / 6.0; sp = sp * r2 * r + r;
    double cp = -1.0 / 87178291200.0; cp = cp * r2 + 1.0 / 479001600.0; cp = cp * r2 - 1.0 / 3628800.0; cp = cp * r2 + 1.0 / 40320.0; cp = cp * r2 - 1.0 / 720.0; cp = cp * r2 + 1.0 / 24.0; cp = cp * r2 - 0.5; cp = cp * r2 + 1.0;
    const int q = (int)((long long)kd & 3);
    const double ss = (q & 1) ? cp : sp, cc = (q & 1) ? sp : cp;
    s = (float)((q & 2) ? -ss : ss); c = (float)(((q + 1) & 2) ? -cc : cc);
}
#define XB_TMO      128
#define XB_XCNT(j)  (256  + 64 * (j))
#define XB_XSUB(j)  (1280 + 64 * (j))
#define XB_XGEN(j)  (2304 + 64 * (j))
#define XB_TOP      3328
#define XB_TOPGEN   3392
#define XCD_BAR_WORDS 3456
#define XB_SPIN_CAP (1u << 18)

__device__ __forceinline__ unsigned xb_ld(unsigned* p)              { return __hip_atomic_load(p, __ATOMIC_RELAXED, __HIP_MEMORY_SCOPE_AGENT); }
__device__ __forceinline__ unsigned xb_add(unsigned* p, unsigned v) { return __hip_atomic_fetch_add(p, v, __ATOMIC_RELAXED, __HIP_MEMORY_SCOPE_AGENT); }
__device__ __forceinline__ unsigned xb_xcc_id() { return (unsigned)__builtin_amdgcn_s_getreg((3 << 11) | 20) & 0xFu; }
#define XB_SPIN(cond, bar) do { unsigned _sp = 0; while (cond) { __builtin_amdgcn_s_sleep(1); \
    if ((++_sp & 255u) == 0u) { if (xb_ld(&(bar)[XB_TMO])) break; if (_sp > XB_SPIN_CAP) { atomicAdd(&(bar)[XB_TMO], 1u); break; } } } } while (0)

struct XcdBarrier {
    unsigned* bar; unsigned x;
    volatile LAS unsigned* st;
};

__device__ __forceinline__ XcdBarrier xcd_barrier_post(unsigned* bar, volatile LAS unsigned* st) {
    XcdBarrier b; b.bar = bar; b.x = xb_xcc_id(); b.st = st;
    if (threadIdx.x == 0) (void)xb_add(&bar[XB_XCNT(b.x)], 1u);
    return b;
}
__device__ __forceinline__ void xcd_barrier_complete(unsigned* bar, unsigned x, unsigned& nloc, unsigned& nx) {
    const unsigned G = gridDim.x * gridDim.y * gridDim.z;
    unsigned sum, cnt, mine, sp = 0u;
    for (;;) {
        sum = 0u; cnt = 0u; mine = 0u;
#pragma unroll
        for (unsigned j = 0; j < 16; ++j) { const unsigned c = xb_ld(&bar[XB_XCNT(j)]); sum += c; cnt += (c > 0u) ? 1u : 0u; mine = (j == x) ? c : mine; }
        if (sum == G) break;
        __builtin_amdgcn_s_sleep(1);
        if ((++sp & 255u) == 0u) { if (xb_ld(&bar[XB_TMO])) break; if (sp > XB_SPIN_CAP) { atomicAdd(&bar[XB_TMO], 1u); break; } }
    }
    nloc = mine > 0u ? mine : 1u; nx = cnt > 0u ? cnt : 1u;
}

__device__ __forceinline__ void xcd_barrier(const XcdBarrier& b) {
    asm volatile("s_waitcnt vmcnt(0)" ::: "memory");
    __syncthreads();
    if (threadIdx.x == 0) {
        unsigned* bar = b.bar;
        __builtin_amdgcn_s_waitcnt(0);
        unsigned nloc = b.st[0], nx = b.st[1];
        if (nloc == 0u) { xcd_barrier_complete(bar, b.x, nloc, nx); b.st[0] = nloc; b.st[1] = nx; }
        const unsigned old = xb_add(&bar[XB_XSUB(b.x)], 1u);
        const unsigned gen = old / nloc;
        if (old + 1u == (gen + 1u) * nloc) {
            __builtin_amdgcn_fence(__ATOMIC_RELEASE, "agent");
            asm volatile("s_waitcnt vmcnt(0)" ::: "memory");
            const unsigned og = xb_add(&bar[XB_TOP], 1u);
            const unsigned tg = og / nx;
            if (og + 1u == (tg + 1u) * nx) xb_add(&bar[XB_TOPGEN], 1u);
            else XB_SPIN(xb_ld(&bar[XB_TOPGEN]) == tg, bar);
            __builtin_amdgcn_fence(__ATOMIC_ACQUIRE, "agent");
            xb_add(&bar[XB_XGEN(b.x)], 1u);
            asm volatile("s_waitcnt vmcnt(0)" ::: "memory");
        } else {
            XB_SPIN(xb_ld(&bar[XB_XGEN(b.x)]) == gen, bar);
            __builtin_amdgcn_fence(__ATOMIC_ACQUIRE, "agent");
            asm volatile("s_waitcnt vmcnt(0)" ::: "memory");
        }
    }
    __syncthreads();
}

struct Ctx { LAS unsigned char* lds; int tid, lane, wave, vcu, G; };

__device__ __forceinline__ void convert_item(const float* W, int K, int N, int IL, bf16* WT, int it, LAS float* scr, int lane) {
    const int nblk = N / 32, kb = it / nblk, nb = it - kb * nblk, n0 = 32 * nb, k0 = 64 * kb;
    int drow0 = n0;
    if (IL > 0) { const int isv = n0 >= IL ? 1 : 0, j = n0 - isv * IL; drow0 = (j >> 7) * 256 + isv * 128 + (j & 127); }
    const float* src = W + (size_t)(k0 + (lane >> 5)) * N + n0 + (lane & 31);
    float v[32];
#pragma unroll
    for (int i = 0; i < 32; ++i) v[i] = src[(size_t)(2 * i) * N];
#pragma unroll
    for (int i = 0; i < 32; ++i) scr[(2 * i + (lane >> 5)) * 33 + (lane & 31)] = v[i];
    LDS_WAIT(); asm volatile("" ::: "memory");
    const int cc = lane & 7;
#pragma unroll
    for (int j = 0; j < 4; ++j) { const int n = (lane >> 3) + 8 * j; const LAS float* s = scr + (8 * cc) * 33 + n;
        u32x4 o; o.x = pk2(s[0 * 33], s[1 * 33]); o.y = pk2(s[2 * 33], s[3 * 33]); o.z = pk2(s[4 * 33], s[5 * 33]); o.w = pk2(s[6 * 33], s[7 * 33]);
        *(u32x4*)(WT + (size_t)(drow0 + n) * K + k0 + 8 * cc) = o; }
    LDS_WAIT(); asm volatile("" ::: "memory");
}
constexpr int CQ_QKV = 9216, CQ_O = 1024, CQ_UP = 11008, CQ_DN = 5504, CQ_IN = 2048, CQ_GLU = 4096;
constexpr int CQ_L = CQ_QKV + CQ_O + CQ_UP + CQ_DN + CQ_IN + CQ_GLU + CQ_UP + CQ_DN;
constexpr int CQ_TOTAL = 2 * CQ_L;
__host__ __device__ constexpr int convq_need(int p) {
    if (p <= 0) return 0; if (p >= N_PHASES) return CQ_TOTAL;
    const int li = (p - 1) / 17, q = (p - 1) % 17;
    int n = li * CQ_L + CQ_QKV; if (q >= 1) n += 0;
    if (q >= 3) n += CQ_O; if (q >= 5) n += CQ_UP; if (q >= 7) n += CQ_DN; if (q >= 9) n += CQ_IN; if (q >= 11) n += CQ_GLU; if (q >= 13) n += CQ_UP; if (q >= 15) n += CQ_DN;
    if (q == 16 && li == 0) n += 0;
    return n;
}
__device__ __forceinline__ void convq_process(LAS unsigned char* lds, int wave, int lane, int it, const float* wqkv, const float* wo, const float* win, const float* wglu, const float* wup, const float* wdn, unsigned char* ws) {
    LAS float* scr = (LAS float*)(lds + wave * 17408);
    const int li = it >= CQ_L ? 1 : 0; int r = it - li * CQ_L;
    const float* W; bf16* WT; int K, N, IL = 0;
    if (r < CQ_QKV) { W = wqkv + (size_t)li * D * NQKV; K = D; N = NQKV; WT = (bf16*)(ws + WS_WQKV + li * WQKV_L); }
    else if ((r -= CQ_QKV) < CQ_O) { W = wo + (size_t)li * AW * D; K = AW; N = D; WT = (bf16*)(ws + WS_WO + li * WO_L); }
    else if ((r -= CQ_O) < CQ_UP) { W = wup + (size_t)(2 * li) * D * FF2; K = D; N = FF2; IL = FF; WT = (bf16*)(ws + WS_WUP + (2 * li) * WUP_L); }
    else if ((r -= CQ_UP) < CQ_DN) { W = wdn + (size_t)(2 * li) * FF * D; K = FF; N = D; WT = (bf16*)(ws + WS_WDN + (2 * li) * WDN_L); }
    else if ((r -= CQ_DN) < CQ_IN) { W = win + (size_t)li * D * D; K = D; N = D; WT = (bf16*)(ws + WS_WIN + li * WIN_L); }
    else if ((r -= CQ_IN) < CQ_GLU) { W = wglu + (size_t)li * D * GLU2; K = D; N = GLU2; IL = 2048; WT = (bf16*)(ws + WS_WGLU + li * WGLU_L); }
    else if ((r -= CQ_GLU) < CQ_UP) { W = wup + (size_t)(2 * li + 1) * D * FF2; K = D; N = FF2; IL = FF; WT = (bf16*)(ws + WS_WUP + (2 * li + 1) * WUP_L); }
    else { r -= CQ_UP; W = wdn + (size_t)(2 * li + 1) * FF * D; K = FF; N = D; WT = (bf16*)(ws + WS_WDN + (2 * li + 1) * WDN_L); }
    convert_item(W, K, N, IL, WT, r, scr, lane);
}
constexpr int CQ_CAPQ = 128 * 8 * CONV_NQ, CQ_CAPU = 160 * 8 * CONV_NU;
__host__ __device__ constexpr bool cq_is_q(int p) { return p >= 1 && ((p - 1) % 17) == 0; }
__host__ __device__ constexpr bool cq_is_u(int p) { return p >= 1 && (((p - 1) % 17) == 5 || ((p - 1) % 17) == 13); }
__host__ __device__ constexpr int cq_min(int a, int b) { return a < b ? a : b; }
__host__ __device__ constexpr int cq_max(int a, int b) { return a > b ? a : b; }
__host__ __device__ constexpr int cq_frontier(int p, int what) {
    int F = convq_need(1);
    for (int k = 1; k <= p; ++k) {
        if (k == p && what == 0) return F;
        if (cq_is_q(k)) F = cq_min(F + CQ_CAPQ, CQ_TOTAL); else if (cq_is_u(k)) F = cq_min(F + CQ_CAPU, CQ_TOTAL);
        if (k == p) return F;
        F = cq_max(F, convq_need(k + 1));
    }
    return F;
}
__device__ __noinline__ void convq_range(LAS unsigned char* lds, int lo, int hi, int rank, int stride, int sync, const float* wqkv, const float* wo, const float* win, const float* wglu, const float* wup, const float* wdn, unsigned char* ws) {
    if (sync) __syncthreads();
    const int lane = threadIdx.x & 63, wave = __builtin_amdgcn_readfirstlane(threadIdx.x >> 6);
    for (int it = lo + rank; it < hi; it += stride) convq_process(lds, wave, lane, it, wqkv, wo, win, wglu, wup, wdn, ws);
}
#define CONVQ_RANGE(lo, hi, rank, stride, sync) convq_range(c.lds, (lo), (hi), (rank), (stride), (sync), args.in[I_WQKV], args.in[I_WO], args.in[I_WIN], args.in[I_WGLU], args.in[I_WUP], args.in[I_WDN], args.ws)
#define CONVQ_SEAM(k) do { constexpr int lo_ = cq_frontier((k), 1), hi_ = convq_need((k) + 1); if (lo_ < hi_) CONVQ_RANGE(lo_, hi_, c.vcu * NWAVES + c.wave, c.G * NWAVES, 1); } while (0)
#define CONVQ_TAIL(p, nbusy, cap) do { constexpr int lo_ = cq_frontier((p), 0), hi_ = cq_min(lo_ + (cap), CQ_TOTAL); \
    if (CONV_TAILS && lo_ < hi_ && (int)blockIdx.x >= (nbusy)) CONVQ_RANGE(lo_, hi_, ((int)blockIdx.x - (nbusy)) * NWAVES + c.wave, ((int)gridDim.x - (nbusy)) * NWAVES, 0); } while (0)
__device__ __forceinline__ void build_cs(const Ctx& c, float* cs) {
    const int gt = (c.vcu * NWAVES + c.wave) * 64 + c.lane, NT = c.G * NWAVES * 64;
    for (int idx = gt; idx < 2049 * 16; idx += NT) {
        const int t = idx >> 4, i = idx & 15;
        const float pos = (t < 2048) ? (float)t : 16384.0f;
        const float inv = __builtin_amdgcn_exp2f(-18.931568569324174f * (float)i * 0.0625f);
        float s, co; sincos_rr(pos * inv, s, co);
        cs[t * 32 + i] = co; cs[t * 32 + 16 + i] = s;
    }
}
__device__ __forceinline__ void prenorm_rows(const Ctx& c, int nrows, const float* x, const float* g, bf16* H) {
    const int gw = c.vcu * NWAVES + c.wave, NGW = c.G * NWAVES;
    if (gw >= nrows) return;
    f32x4 gv[8], xn[8];
#pragma unroll
    for (int j = 0; j < 8; ++j) { gv[j] = *(const f32x4*)(g + 4 * c.lane + 256 * j); xn[j] = *(const f32x4*)(x + (size_t)gw * D + 4 * c.lane + 256 * j); }
    for (int row = gw; row < nrows; row += NGW) {
        f32x4 v[8]; float ss = 0.f;
#pragma unroll
        for (int j = 0; j < 8; ++j) { v[j] = xn[j]; ss += (v[j].x * v[j].x + v[j].y * v[j].y) + (v[j].z * v[j].z + v[j].w * v[j].w); }
        if (row + NGW < nrows) {
#pragma unroll
            for (int j = 0; j < 8; ++j) xn[j] = *(const f32x4*)(x + (size_t)(row + NGW) * D + 4 * c.lane + 256 * j); }
        const float rstd = 1.0f / sqrtf(wave_sum(ss) * (1.0f / D) + RMS_EPS);
#pragma unroll
        for (int j = 0; j < 8; ++j) { const f32x4 h = v[j] * rstd * gv[j];
            u32x2 w; w.x = pk2(h.x, h.y); w.y = pk2(h.z, h.w); *(u32x2*)(H + (size_t)row * D + 4 * c.lane + 256 * j) = w; }
    }
}
template <bool GLU, bool ZERO_M = false, bool MBF = false> __device__ __forceinline__ void postnorm_rows(const Ctx& c, int nrows, const float* xin, float* xout, const float* M, int ldm, const float* g1, const float* g2, bf16* H, float mscale = 1.0f) {
    const int gw = c.vcu * NWAVES + c.wave, NGW = c.G * NWAVES;
    if (gw >= nrows) return;
    f32x4 ga[8], gb[8];
#pragma unroll
    for (int j = 0; j < 8; ++j) { const int col = 4 * c.lane + 256 * j; ga[j] = *(const f32x4*)(g1 + col); gb[j] = g2 ? *(const f32x4*)(g2 + col) : (f32x4){0.f, 0.f, 0.f, 0.f}; }
    f32x4 v[8], xv[8]; u32x2 mw[8];
    auto load_row = [&](int row) {
        const float* mr = M + (size_t)row * ldm;
#pragma unroll
        for (int j = 0; j < 8; ++j) { const int col = 4 * c.lane + 256 * j;
            if (MBF) mw[j] = *(const u32x2*)((const bf16*)M + (size_t)row * ldm + col);
            else if (!GLU) { v[j] = *(const f32x4*)(mr + col); if (ZERO_M) *(f32x4*)const_cast<float*>(mr + col) = (f32x4){0.f, 0.f, 0.f, 0.f}; }
            else { const float* pa = mr + (col >> 7) * 256 + (col & 127); const f32x4 a = *(const f32x4*)pa, gt = *(const f32x4*)(pa + 128);
                if (ZERO_M) { *(f32x4*)const_cast<float*>(pa) = (f32x4){0.f, 0.f, 0.f, 0.f}; *(f32x4*)const_cast<float*>(pa + 128) = (f32x4){0.f, 0.f, 0.f, 0.f}; }
                v[j].x = a.x * sigmoidf_(gt.x); v[j].y = a.y * sigmoidf_(gt.y); v[j].z = a.z * sigmoidf_(gt.z); v[j].w = a.w * sigmoidf_(gt.w); }
            xv[j] = *(const f32x4*)(xin + (size_t)row * D + col); }
    };
    load_row(gw);
    for (int row = gw; row < nrows; row += NGW) {
        f32x4 xc[8]; u32x2 mc[8]; float ss = 0.f;
#pragma unroll
        for (int j = 0; j < 8; ++j) { if (MBF) mc[j] = mw[j]; else xc[j] = v[j];
            const f32x4 y = MBF ? (f32x4){bflo(mc[j].x), bfhi(mc[j].x), bflo(mc[j].y), bfhi(mc[j].y)} : xc[j];
            ss += (y.x * y.x + y.y * y.y) + (y.z * y.z + y.w * y.w); }
        f32x4 xo[8];
#pragma unroll
        for (int j = 0; j < 8; ++j) xo[j] = xv[j];
        if (MBF && row + NGW < nrows) load_row(row + NGW);
        const float rstd = 1.0f / sqrtf(wave_sum(ss) * (1.0f / D) + RMS_EPS);
        float ss2 = 0.f;
#pragma unroll
        for (int j = 0; j < 8; ++j) { const int col = 4 * c.lane + 256 * j;
            const f32x4 y = MBF ? (f32x4){bflo(mc[j].x), bfhi(mc[j].x), bflo(mc[j].y), bfhi(mc[j].y)} : xc[j];
            const f32x4 xn = xo[j] + y * (rstd * mscale) * ga[j]; *(f32x4*)(xout + (size_t)row * D + col) = xn; xo[j] = xn;
            ss2 += (xn.x * xn.x + xn.y * xn.y) + (xn.z * xn.z + xn.w * xn.w); }
        if (g2) {
            const float rstd2 = 1.0f / sqrtf(wave_sum(ss2) * (1.0f / D) + RMS_EPS);
#pragma unroll
            for (int j = 0; j < 8; ++j) { const int col = 4 * c.lane + 256 * j; const f32x4 h = xo[j] * rstd2 * gb[j];
                u32x2 w; w.x = pk2(h.x, h.y); w.y = pk2(h.z, h.w); *(u32x2*)(H + (size_t)row * D + col) = w; }
        }
    }
}


template <int KSL = 3> __device__ __forceinline__ void skinny_gemm(const Ctx& c, const bf16* A, const bf16* Bt, int N, int K, float* out, int first_wg = 0) {
    const int nks = K / 32, ncg = N / 16;
    const int cq = c.lane & 15, rq = c.lane >> 4;
    if ((int)blockIdx.x < first_wg) return;
    const int nw = c.G - first_wg, me = first_wg ? (int)blockIdx.x - first_wg : c.vcu;
    for (int it = c.wave * nw + me; it < (ncg << KSL); it += nw * NWAVES) {
        const int cg = it >> KSL, kp = it & ((1 << KSL) - 1), ks0 = (kp * nks) >> KSL, ks1 = ((kp + 1) * nks) >> KSL;
        const bf16* bp = Bt + (size_t)(16 * cg + cq) * K + 8 * rq; const bf16* ap = A + (size_t)(cq & 7) * K + 8 * rq;
        f32x4 acc = (f32x4){0.f, 0.f, 0.f, 0.f};
#pragma unroll 4
        for (int ks = ks0; ks < ks1; ++ks) acc = __builtin_amdgcn_mfma_f32_16x16x32_bf16(*(const bf16x8*)(bp + 32 * ks), *(const bf16x8*)(ap + 32 * ks), acc, 0, 0, 0);
        if (cq < 8) { float* o = out + (size_t)cq * N + 16 * cg + 4 * rq;
#pragma unroll
            for (int e = 0; e < 4; ++e) unsafeAtomicAdd(o + e, acc[e]); }
    }
}
__device__ __forceinline__ void zero_f32(const Ctx& c, float* p, int n) {
    const int gt = (c.vcu * NWAVES + c.wave) * 64 + c.lane, NT = c.G * NWAVES * 64;
    for (int i = gt; i < n; i += NT) p[i] = 0.f;
}

constexpr int AT_KP = 272, AT_VP = 528, AT_VOFF = 256 * AT_KP;
struct AttnItem { int g, dsh, r, qt, bgh, base, row0; };
__device__ __forceinline__ AttnItem attn_item(int it) {
    AttnItem a; const int bh = it / 48, rem = it - bh * 48, sub = rem & 15, b = bh >> 3, h = bh & 7;
    a.g = rem >> 4; a.dsh = 2 * a.g; a.r = sub >> (4 - a.dsh); a.qt = sub & ((16 >> a.dsh) - 1);
    a.bgh = (b * 3 + a.g) * 8 + h; a.base = a.r * (2048 >> a.dsh); a.row0 = b * 2048; return a;
}
__device__ __forceinline__ void attn_stage_load(const AttnItem& a, const bf16* K, const bf16* V, int tid, u32x4 (&kr)[8], u32x4 (&vr)[8]) {
    const bf16* Kp = K + (size_t)a.bgh * 2048 * 128; const bf16* Vp = V + (size_t)a.bgh * 2048 * 128;
    const int kw0 = 128 * a.qt - 128, c16 = tid & 15, o = tid >> 4;
#pragma unroll
    for (int i = 0; i < 8; ++i) { int ks = kw0 + 32 * i + o; ks = ks < 0 ? 0 : ks;
        kr[i] = *(const u32x4*)(Kp + (size_t)(a.base + ks) * 128 + 8 * c16);
        int kv = kw0 + 8 * o + i; kv = kv < 0 ? 0 : kv;
        vr[i] = *(const u32x4*)(Vp + (size_t)(a.base + kv) * 128 + 8 * c16); }
}
__device__ __forceinline__ void attn_stage_store(LAS unsigned char* lds, int tid, const u32x4 (&kr)[8], const u32x4 (&vr)[8]) {
    const int c16 = tid & 15, o = tid >> 4;
#pragma unroll
    for (int i = 0; i < 8; ++i) *(LAS u32x4*)(lds + (32 * i + o) * AT_KP + 16 * c16) = kr[i];
#pragma unroll
    for (int e = 0; e < 8; ++e) { const unsigned sel = (e & 1) ? 0x07060302u : 0x05040100u; u32x4 w;
#pragma unroll
        for (int m = 0; m < 4; ++m) w[m] = __builtin_amdgcn_perm(vr[2 * m + 1][e >> 1], vr[2 * m][e >> 1], sel);
        *(LAS u32x4*)(lds + AT_VOFF + (8 * c16 + e) * AT_VP + 16 * (o ^ (c16 & 7))) = w; }
}
__device__ __forceinline__ void attn_prompt(const Ctx& c, const bf16* Q, const bf16* K, const bf16* VT, bf16* OG, float* LSE, float* LL) {
    const int cq = c.lane & 15, rq = c.lane >> 4, w = c.wave;
    u32x4 kr[8], vr[8]; bf16x8 qn[4];
    int it = c.vcu;
    if (it < 1536) { const AttnItem a0 = attn_item(it); attn_stage_load(a0, K, VT, c.tid, kr, vr);
#pragma unroll
        for (int ks = 0; ks < 4; ++ks) qn[ks] = *(const bf16x8*)(Q + ((size_t)a0.bgh * 2048 + a0.base + 128 * a0.qt + 16 * w + cq) * 128 + 32 * ks + 8 * rq); }
    for (; it < 1536; it += c.G) {
        const AttnItem a = attn_item(it);
        attn_stage_store(c.lds, c.tid, kr, vr);
        bf16x8 qf[4];
#pragma unroll
        for (int ks = 0; ks < 4; ++ks) qf[ks] = qn[ks];
        __syncthreads();
        if (it + c.G < 1536) { const AttnItem an = attn_item(it + c.G); attn_stage_load(an, K, VT, c.tid, kr, vr);
#pragma unroll
            for (int ks = 0; ks < 4; ++ks) qn[ks] = *(const bf16x8*)(Q + ((size_t)an.bgh * 2048 + an.base + 128 * an.qt + 16 * w + cq) * 128 + 32 * ks + 8 * rq); }
        const int dsh = a.dsh, g = a.g;
        const int s0 = 128 * a.qt + 16 * w, kb = s0 - 128;
        f32x4 st[9];
#pragma unroll
        for (int j = 0; j < 9; ++j) {
            const int krow = 16 * w + (j < 8 ? 32 * (j >> 1) + 8 * (cq >> 2) + 4 * (j & 1) + (cq & 3) : 128 + cq);
            const LAS unsigned char* kl = c.lds + krow * AT_KP + 16 * rq;
            f32x4 acc = (f32x4){0.f, 0.f, 0.f, 0.f};
#pragma unroll
            for (int ks = 0; ks < 4; ++ks) acc = __builtin_amdgcn_mfma_f32_16x16x32_bf16(*(const LAS bf16x8*)(kl + 64 * ks), qf[ks], acc, 0, 0, 0);
            st[j] = acc;
        }
        const int qs = s0 + cq, lo = (qs - 128) < 0 ? 0 : (qs - 128);
        float mx = -1e30f;
#pragma unroll
        for (int j = 0; j < 9; ++j)
#pragma unroll
            for (int e = 0; e < 4; ++e) { const int ksub = kb + (j < 8 ? 32 * (j >> 1) + 8 * rq + 4 * (j & 1) + e : 128 + 4 * rq + e); const bool ok = (ksub >= lo) && (ksub <= qs);
                const float v = ok ? st[j][e] : -1e30f; st[j][e] = v; mx = fmaxf(mx, v); }
        mx = fmaxf(mx, __shfl_xor(mx, 16)); mx = fmaxf(mx, __shfl_xor(mx, 32));
        float l = 0.f;
#pragma unroll
        for (int j = 0; j < 9; ++j)
#pragma unroll
            for (int e = 0; e < 4; ++e) { const float pv = __builtin_amdgcn_exp2f(st[j][e] - mx); st[j][e] = pv; l += pv; }
        l += __shfl_xor(l, 16); l += __shfl_xor(l, 32);
        bf16x8 pf[4];
#pragma unroll
        for (int p = 0; p < 4; ++p) { u32x4 wv; wv.x = pk2(st[2 * p][0], st[2 * p][1]); wv.y = pk2(st[2 * p][2], st[2 * p][3]); wv.z = pk2(st[2 * p + 1][0], st[2 * p + 1][1]); wv.w = pk2(st[2 * p + 1][2], st[2 * p + 1][3]);
            pf[p] = __builtin_bit_cast(bf16x8, wv); }
        u32x2 w8; w8.x = pk2(st[8][0], st[8][1]); w8.y = pk2(st[8][2], st[8][3]);
        const bf16x4 pf8 = __builtin_bit_cast(bf16x4, w8);
        const float rl = 1.0f / l;
        const int row = a.row0 + ((s0 + cq) << dsh) + a.r, h = a.bgh & 7;
        bf16* orow = OG + ((size_t)g * MP + row) * AW + h * 128 + 4 * rq;
#pragma unroll
        for (int i = 0; i < 8; ++i) {
            f32x4 acc = (f32x4){0.f, 0.f, 0.f, 0.f};
            const LAS unsigned char* vl = c.lds + AT_VOFF + (16 * i + cq) * AT_VP; const int swz = (2 * i + (cq >> 3)) & 7;
#pragma unroll
            for (int p = 0; p < 4; ++p) acc = __builtin_amdgcn_mfma_f32_16x16x32_bf16(*(const LAS bf16x8*)(vl + 16 * ((2 * w + 4 * p + rq) ^ swz)), pf[p], acc, 0, 0, 0);
            acc = __builtin_amdgcn_mfma_f32_16x16x16bf16_1k(*(const LAS bf16x4*)(vl + 16 * ((2 * w + 16 + (rq >> 1)) ^ swz) + 8 * (rq & 1)), pf8, acc, 0, 0, 0);
            u32x2 wv; wv.x = pk2(acc[0] * rl, acc[1] * rl); wv.y = pk2(acc[2] * rl, acc[3] * rl);
            *(u32x2*)(orow + 16 * i) = wv;
        }
        if (rq == 0) { LSE[((size_t)g * MP + row) * 8 + h] = (mx + __builtin_amdgcn_logf(l)) * 0.6931471805599453f; LL[((size_t)g * MP + row) * 8 + h] = l; }
        __syncthreads();
    }
}
__device__ __forceinline__ void merge_prompt(const Ctx& c, const bf16* OG, const float* LSE, const float* LL, bf16* O) {
    const int gw = c.vcu * NWAVES + c.wave, NGW = c.G * NWAVES, head = c.lane >> 3;
    u32x4 og[3][2]; float ls[3], lh[3], lz[3];
    auto load_row = [&](int row) {
#pragma unroll
        for (int gi = 0; gi < 3; ++gi) { const size_t i = ((size_t)gi * MP + row) * 8; ls[gi] = LSE[i + head]; lh[gi] = LL[i + head]; lz[gi] = LL[i];
#pragma unroll
            for (int hf = 0; hf < 2; ++hf) og[gi][hf] = *(const u32x4*)(OG + ((size_t)gi * MP + row) * AW + 16 * c.lane + 8 * hf); }
    };
    if (gw < MP) load_row(gw);
    for (int row = gw; row < MP; row += NGW) {
        u32x4 a[2], bq[2], cc[2];
#pragma unroll
        for (int hf = 0; hf < 2; ++hf) { a[hf] = og[0][hf]; bq[hf] = og[1][hf]; cc[hf] = og[2][hf]; }
        const float l0 = ls[0], l1 = ls[1], l2 = ls[2];
        const float m = fmaxf(l0, fmaxf(l1, l2)); float w0 = __expf(l0 - m), w1 = __expf(l1 - m), w2 = __expf(l2 - m); const float inv = 1.0f / (w0 + w1 + w2);
        w0 *= inv * lh[0] / lz[0]; w1 *= inv * lh[1] / lz[1]; w2 *= inv * lh[2] / lz[2];
        if (row + NGW < MP) load_row(row + NGW);
#pragma unroll
        for (int hf = 0; hf < 2; ++hf) { const int col = 16 * c.lane + 8 * hf;
            u32x4 o;
#pragma unroll
            for (int e = 0; e < 4; ++e) { const float lo = w0 * bflo(a[hf][e]) + w1 * bflo(bq[hf][e]) + w2 * bflo(cc[hf][e]), hi = w0 * bfhi(a[hf][e]) + w1 * bfhi(bq[hf][e]) + w2 * bfhi(cc[hf][e]); o[e] = pk2(lo, hi); }
            *(u32x4*)(O + (size_t)row * AW + col) = o; }
    }
}

template <int GG> __device__ __forceinline__ void attn_sample(const Ctx& c, int li, const float* QKVS, const float* cs, const float* ck, float* OSG, float* LSES, float* kvsb) {
    LAS float* sh = (LAS float*)c.lds;
    const float* csr = cs + 2048 * 32;
    constexpr int g = GG, dil = 1 << (2 * GG), L = 128 << (2 * GG);
    for (int it = c.vcu - 64 * GG; it >= 0 && it < 64; it += c.G) {
        const int b = it >> 3, h = it & 7;
        const float* cache = ck + ((size_t)(li * 8 + b) * L) * 2048;
        float* kvs = kvsb + (size_t)(li * 8 + b) * 2048;
        const float* qrow = QKVS + (size_t)b * NQKV + g * 1024 + h * 128;
        if (c.tid < 128) { const int d = c.tid;
            float qv = qrow[d], kv = qrow[3072 + d]; const float vv = qrow[6144 + d];
            if (d < 16) { const float co = csr[d], si = csr[16 + d]; const float q2 = qrow[d + 16], k2 = qrow[3072 + d + 16]; qv = qv * co - q2 * si; kv = kv * co - k2 * si; }
            else if (d < 32) { const float co = csr[d - 16], si = csr[d]; const float q1 = qrow[d - 16], k1 = qrow[3072 + d - 16]; qv = qv * co + q1 * si; kv = kv * co + k1 * si; }
            sh[d] = qv * 0.08838834764831845f; sh[128 + d] = kv; sh[256 + d] = vv;
            kvs[h * 128 + d] = kv; kvs[1024 + h * 128 + d] = vv; }
        __syncthreads();
        if (c.tid < 128) { float* qz = const_cast<float*>(qrow); qz[c.tid] = 0.f; qz[3072 + c.tid] = 0.f; qz[6144 + c.tid] = 0.f; }
        const f32x2 q2 = *(const LAS f32x2*)(sh + 2 * c.lane);
        float m = -1e30f, l = 0.f; f32x2 acc = (f32x2){0.f, 0.f};
        f32x2 kk[17], vv[17];
#pragma unroll
        for (int t = 0; t < 17; ++t) { const int jj = c.wave + 8 * t;
            if (jj == 0) { kk[t] = *(const LAS f32x2*)(sh + 128 + 2 * c.lane); vv[t] = *(const LAS f32x2*)(sh + 256 + 2 * c.lane); }
            else { const int jc = jj <= 128 ? jj : 128; const float* rp = cache + (size_t)(L - dil * jc) * 2048 + h * 128 + 2 * c.lane; kk[t] = *(const f32x2*)rp; vv[t] = *(const f32x2*)(rp + 1024); } }
        float sc_[17];
#pragma unroll
        for (int t = 0; t < 17; ++t) sc_[t] = q2.x * kk[t].x + q2.y * kk[t].y;
#pragma unroll
        for (int o = 1; o < 64; o <<= 1)
#pragma unroll
            for (int t = 0; t < 17; ++t) sc_[t] += __shfl_xor(sc_[t], o);
#pragma unroll
        for (int t = 0; t < 17; ++t) { const int jj = c.wave + 8 * t;
            if (jj <= 128) {
                const float s = sc_[t];
                const float mn = fmaxf(m, s), sc = __expf(m - mn), pe = __expf(s - mn);
                l = l * sc + pe; acc = acc * sc + vv[t] * pe; m = mn; } }
        LAS float* pw = sh + 512 + c.wave * 132;
        if (c.lane == 0) { pw[0] = m; pw[1] = l; }
        *(LAS f32x2*)(pw + 4 + 2 * c.lane) = acc;
        __syncthreads();
        if (c.wave == 0) {
            float M = -1e30f;
#pragma unroll
            for (int w = 0; w < 8; ++w) M = fmaxf(M, sh[512 + w * 132]);
            float Lt = 0.f; f32x2 o = (f32x2){0.f, 0.f};
#pragma unroll
            for (int w = 0; w < 8; ++w) { const float f = __expf(sh[512 + w * 132] - M); Lt += sh[512 + w * 132 + 1] * f; o += *(const LAS f32x2*)(sh + 512 + w * 132 + 4 + 2 * c.lane) * f; }
            const float rl = 1.0f / Lt;
            *(f32x2*)(OSG + ((size_t)g * 8 + b) * 1024 + h * 128 + 2 * c.lane) = o * rl;
            if (c.lane == 0) { LSES[(g * 8 + b) * 8 + h] = M + __logf(Lt); LSES[256 + (g * 8 + b) * 8 + h] = Lt; }
        }
        __syncthreads();
    }
}
__device__ __forceinline__ void merge_sample(const Ctx& c, const float* OSG, const float* LSES, bf16* OS) {
    if (c.vcu != 0) return;
    const int b = c.wave, head = c.lane >> 3;
    const float l0 = LSES[(0 * 8 + b) * 8 + head], l1 = LSES[(1 * 8 + b) * 8 + head], l2 = LSES[(2 * 8 + b) * 8 + head];
    const float m = fmaxf(l0, fmaxf(l1, l2)); float w0 = __expf(l0 - m), w1 = __expf(l1 - m), w2 = __expf(l2 - m); const float inv = 1.0f / (w0 + w1 + w2);
    w0 *= inv * LSES[256 + (0 * 8 + b) * 8 + head] / LSES[256 + (0 * 8 + b) * 8]; w1 *= inv * LSES[256 + (1 * 8 + b) * 8 + head] / LSES[256 + (1 * 8 + b) * 8]; w2 *= inv * LSES[256 + (2 * 8 + b) * 8 + head] / LSES[256 + (2 * 8 + b) * 8];
#pragma unroll
    for (int e = 0; e < 16; e += 2) { const int col = 16 * c.lane + e;
        const float lo = w0 * OSG[(0 * 8 + b) * 1024 + col] + w1 * OSG[(1 * 8 + b) * 1024 + col] + w2 * OSG[(2 * 8 + b) * 1024 + col];
        const float hi = w0 * OSG[(0 * 8 + b) * 1024 + col + 1] + w1 * OSG[(1 * 8 + b) * 1024 + col + 1] + w2 * OSG[(2 * 8 + b) * 1024 + col + 1];
        *(unsigned*)(OS + (size_t)b * 1024 + col) = pk2(lo, hi); }
}

__device__ __forceinline__ void conv_prompt(const Ctx& c, const bf16* U, bf16* ACT, const float* cw, const float* cb, float* convp) {
    const int gw = c.vcu * NWAVES + c.wave, NGW = c.G * NWAVES, cl = c.lane & 15, rg = c.lane >> 4;
    for (int it = gw; it < 128 * 43; it += NGW) {
        const int rb = it / 43, pn = it - rb * 43;
        const int gcol = 128 * pn + 8 * cl, vcol = FF + gcol;
        float wg[3][8], wv[3][8], bg[8], bv[8];
#pragma unroll
        for (int e = 0; e < 8; ++e) { bg[e] = cb[gcol + e]; bv[e] = cb[vcol + e];
#pragma unroll
            for (int j = 0; j < 3; ++j) { wg[j][e] = cw[j * FF2 + gcol + e]; wv[j][e] = cw[j * FF2 + vcol + e]; } }
        const int row0 = rb * 64 + rg * 16;
        float g1[8], g2[8], v1[8], v2[8];
#pragma unroll
        for (int e = 0; e < 8; ++e) { g1[e] = 0.f; g2[e] = 0.f; v1[e] = 0.f; v2[e] = 0.f; }
        if ((row0 & 2047) != 0) {
            const u32x4 a1 = *(const u32x4*)(U + (size_t)(row0 - 1) * FF2 + 256 * pn + 8 * cl), b1 = *(const u32x4*)(U + (size_t)(row0 - 1) * FF2 + 256 * pn + 128 + 8 * cl);
            const u32x4 a2 = *(const u32x4*)(U + (size_t)(row0 - 2) * FF2 + 256 * pn + 8 * cl), b2 = *(const u32x4*)(U + (size_t)(row0 - 2) * FF2 + 256 * pn + 128 + 8 * cl);
#pragma unroll
            for (int e = 0; e < 4; ++e) { g1[2 * e] = bflo(a1[e]); g1[2 * e + 1] = bfhi(a1[e]); v1[2 * e] = bflo(b1[e]); v1[2 * e + 1] = bfhi(b1[e]);
                g2[2 * e] = bflo(a2[e]); g2[2 * e + 1] = bfhi(a2[e]); v2[2 * e] = bflo(b2[e]); v2[2 * e + 1] = bfhi(b2[e]); }
        }
        for (int rr = 0; rr < 16; ++rr) {
            const int row = row0 + rr;
            const u32x4 a0 = *(const u32x4*)(U + (size_t)row * FF2 + 256 * pn + 8 * cl), b0 = *(const u32x4*)(U + (size_t)row * FF2 + 256 * pn + 128 + 8 * cl);
            float g0[8], v0[8], act[8];
#pragma unroll
            for (int e = 0; e < 4; ++e) { g0[2 * e] = bflo(a0[e]); g0[2 * e + 1] = bfhi(a0[e]); v0[2 * e] = bflo(b0[e]); v0[2 * e + 1] = bfhi(b0[e]); }
#pragma unroll
            for (int e = 0; e < 8; ++e) { const float cg = bg[e] + wg[0][e] * g2[e] + wg[1][e] * g1[e] + wg[2][e] * g0[e], cv = bv[e] + wv[0][e] * v2[e] + wv[1][e] * v1[e] + wv[2][e] * v0[e];
                act[e] = cg * sigmoidf_(cg) * cv; g2[e] = g1[e]; g1[e] = g0[e]; v2[e] = v1[e]; v1[e] = v0[e]; }
            u32x4 o; o.x = pk2(act[0], act[1]); o.y = pk2(act[2], act[3]); o.z = pk2(act[4], act[5]); o.w = pk2(act[6], act[7]);
            *(u32x4*)(ACT + (size_t)row * FF + gcol) = o;
            const int t = row & 2047;
            if (t >= 2046) { float* o1 = convp + ((size_t)(row >> 11) * 2 + (t - 2046)) * FF2;
#pragma unroll
                for (int e = 0; e < 8; ++e) { o1[gcol + e] = g0[e]; o1[vcol + e] = v0[e]; } }
        }
    }
}
__device__ __forceinline__ void conv_sample(const Ctx& c, const float* US, const float* st, bf16* ACTS, const float* cw, const float* cb, float* convs) {
    const int gt = (c.vcu * NWAVES + c.wave) * 64 + c.lane, NT = c.G * NWAVES * 64;
    for (int idx = gt; idx < 8 * FF; idx += NT) {
        const int b = idx / FF, j = idx - b * FF, pn = j >> 7, jj = j & 127;
        const float ug = US[(size_t)b * FF2 + 256 * pn + jj], uv = US[(size_t)b * FF2 + 256 * pn + 128 + jj];
        { float* uz = const_cast<float*>(US); uz[(size_t)b * FF2 + 256 * pn + jj] = 0.f; uz[(size_t)b * FF2 + 256 * pn + 128 + jj] = 0.f; }
        const float* s0 = st + (size_t)b * 2 * FF2; const float* s1 = s0 + FF2;
        const float cg = cb[j] + cw[j] * s0[j] + cw[FF2 + j] * s1[j] + cw[2 * FF2 + j] * ug;
        const float cv = cb[FF + j] + cw[FF + j] * s0[FF + j] + cw[FF2 + FF + j] * s1[FF + j] + cw[2 * FF2 + FF + j] * uv;
        ACTS[(size_t)b * FF + j] = (bf16)(pk2(cg * sigmoidf_(cg) * cv, 0.f) & 0xffffu);
        float* o = convs + (size_t)b * 2 * FF2; o[j] = s1[j]; o[FF + j] = s1[FF + j]; o[FF2 + j] = ug; o[FF2 + FF + j] = uv;
    }
}


__device__ __forceinline__ void conv_fixup(const Ctx& c, const float* part, const float* halou, bf16* ACT, const float* cw) {
    const int gt = (c.vcu * NWAVES + c.wave) * 64 + c.lane, NT = c.G * NWAVES * 64;
    for (int idx = gt; idx < 32 * 2 * FF; idx += NT) {
        const int pm = idx / (2 * FF), rem = idx - pm * 2 * FF, r = rem / FF, j = rem - r * FF, pn = j >> 7, jj = j & 127;
        if ((pm & 7) == 0) continue;
        const size_t ci = 256 * pn + jj;
        float cg = part[((size_t)pm * 2 + r) * FF2 + ci], cv = part[((size_t)pm * 2 + r) * FF2 + ci + 128];
        const float ug2 = halou[((size_t)(pm - 1) * 2 + 0) * FF2 + ci], ug1 = halou[((size_t)(pm - 1) * 2 + 1) * FF2 + ci];
        const float uv2 = halou[((size_t)(pm - 1) * 2 + 0) * FF2 + ci + 128], uv1 = halou[((size_t)(pm - 1) * 2 + 1) * FF2 + ci + 128];
        if (r == 0) { cg += cw[j] * ug2 + cw[FF2 + j] * ug1; cv += cw[FF + j] * uv2 + cw[FF2 + FF + j] * uv1; }
        else { cg += cw[j] * ug1; cv += cw[FF + j] * uv1; }
        ACT[((size_t)pm * 256 + r) * FF + j] = (bf16)(pk2(cg * sigmoidf_(cg) * cv, 0.f) & 0xffffu);
    }
}

__device__ __forceinline__ void ssm_prompt(const Ctx& c, const bf16* US, bf16* Z, const float* lam_re, const float* lam_im, const float* log_dt, const float* b_re, const float* b_im,
                                           const float* c_re, const float* c_im, const float* d_skip, float* ssm_out) {
    const int lane = c.lane, cq = lane & 15, rq = lane >> 4, sq = c.wave >> 2, q = c.wave & 3;
    LAS unsigned* BU = (LAS unsigned*)(c.lds + c.wave * 12544);
    LAS unsigned char* XL = c.lds + c.wave * 12544 + 8192;
    LAS f32x2* EX = (LAS f32x2*)(c.lds + 8 * 12544);
    for (int it0 = c.vcu; it0 < 256; it0 += c.G) {
        const int it = sq * 256 + it0, b = it >> 7, g = it & 127;
        const float lr = fminf(lam_re[g * 64 + lane], -1e-4f), lim = lam_im[g * 64 + lane], dt = __expf(log_dt[g]);
        const float mag = __expf(lr * dt); float sn, cs_; sincos_rr(lim * dt, sn, cs_);
        const float ar = mag * cs_, ai = mag * sn;
        const float den = 1.0f / (lr * lr + lim * lim), nr = ar - 1.0f;
        const float cr = (nr * lr + ai * lim) * den, ci = (ai * lr - nr * lim) * den;
        bf16x4 bb[8];
#pragma unroll
        for (int jn = 0; jn < 8; ++jn) { const int pp = 16 * (jn & 3) + cq; const float crr = __shfl(cr, pp), cii = __shfl(ci, pp);
            const f32x4 br = *(const f32x4*)(b_re + (size_t)(g * 64 + pp) * 16 + 4 * rq), bi = *(const f32x4*)(b_im + (size_t)(g * 64 + pp) * 16 + 4 * rq);
            float v[4];
#pragma unroll
            for (int e = 0; e < 4; ++e) v[e] = (jn >= 4) ? (crr * bi[e] + cii * br[e]) : (crr * br[e] - cii * bi[e]);
            u32x2 wv; wv.x = pk2(v[0], v[1]); wv.y = pk2(v[2], v[3]); bb[jn] = __builtin_bit_cast(bf16x4, wv); }
        const size_t rowbase = (size_t)b * 2048 + 512 * q;
        float xr = 0.f, xi = 0.f;
        const bf16* up0 = US + (rowbase + cq) * 2048 + 16 * g + 4 * rq;
        bf16x4 ua = *(const bf16x4*)up0, ub = *(const bf16x4*)(up0 + (size_t)16 * 2048);
        for (int ch = 0; ch < 32; ++ch) {
            const bf16x4 ua_n = *(const bf16x4*)(up0 + (size_t)(ch < 30 ? ch + 2 : 31) * 16 * 2048);
#pragma unroll
            for (int jn = 0; jn < 4; ++jn) { f32x4 dr = __builtin_amdgcn_mfma_f32_16x16x16bf16_1k(ua, bb[jn], (f32x4){0.f, 0.f, 0.f, 0.f}, 0, 0, 0), di = __builtin_amdgcn_mfma_f32_16x16x16bf16_1k(ua, bb[jn + 4], (f32x4){0.f, 0.f, 0.f, 0.f}, 0, 0, 0);
#pragma unroll
                for (int e = 0; e < 4; ++e) BU[(4 * rq + e) * 64 + 16 * jn + cq] = pk2v(dr[e], di[e]); }
            LDS_WAIT();
#pragma unroll
            for (int tt = 0; tt < 16; ++tt) { const unsigned bw = BU[tt * 64 + lane]; const f32x2 bu = (f32x2){bflo(bw), bfhi(bw)};
                const float nxr = __builtin_fmaf(ar, xr, __builtin_fmaf(-ai, xi, bu.x)), nxi = __builtin_fmaf(ar, xi, __builtin_fmaf(ai, xr, bu.y)); xr = nxr; xi = nxi; }
            LDS_WAIT();
            ua = ub; ub = ua_n;
        }
        EX[(sq * 4 + q) * 64 + lane] = (f32x2){xr, xi};
        __syncthreads();
        float pr = ar, pi = ai;
#pragma unroll
        for (int k = 0; k < 9; ++k) { const float t = pr * pr - pi * pi; pi = 2.0f * pr * pi; pr = t; }
        xr = 0.f; xi = 0.f;
        for (int qq = 0; qq < q; ++qq) { const f32x2 e = EX[(sq * 4 + qq) * 64 + lane]; const float nxr = pr * xr - pi * xi + e.x, nxi = pr * xi + pi * xr + e.y; xr = nxr; xi = nxi; }
        bf16x8 cf[4];
#pragma unroll
        for (int ks = 0; ks < 4; ++ks) { const f32x4 cre = *(const f32x4*)(c_re + (size_t)(g * 16 + cq) * 64 + 16 * ks + 4 * rq), cim = *(const f32x4*)(c_im + (size_t)(g * 16 + cq) * 64 + 16 * ks + 4 * rq);
            u32x4 wv; wv.x = pk2(cre[0], -cim[0]); wv.y = pk2(cre[1], -cim[1]); wv.z = pk2(cre[2], -cim[2]); wv.w = pk2(cre[3], -cim[3]); cf[ks] = __builtin_bit_cast(bf16x8, wv); }
        const f32x4 dsk = *(const f32x4*)(d_skip + 16 * g + 4 * rq);
        ua = *(const bf16x4*)up0; ub = *(const bf16x4*)(up0 + (size_t)16 * 2048);
        for (int ch = 0; ch < 32; ++ch) {
            const size_t off = (rowbase + 16 * ch + cq) * 2048 + 16 * g + 4 * rq;
            const bf16x4 ua_n = *(const bf16x4*)(up0 + (size_t)(ch < 30 ? ch + 2 : 31) * 16 * 2048);
#pragma unroll
            for (int jn = 0; jn < 4; ++jn) { f32x4 dr = __builtin_amdgcn_mfma_f32_16x16x16bf16_1k(ua, bb[jn], (f32x4){0.f, 0.f, 0.f, 0.f}, 0, 0, 0), di = __builtin_amdgcn_mfma_f32_16x16x16bf16_1k(ua, bb[jn + 4], (f32x4){0.f, 0.f, 0.f, 0.f}, 0, 0, 0);
#pragma unroll
                for (int e = 0; e < 4; ++e) BU[(4 * rq + e) * 64 + 16 * jn + cq] = pk2v(dr[e], di[e]); }
            LDS_WAIT();
#pragma unroll
            for (int tt = 0; tt < 16; ++tt) { const unsigned bw = BU[tt * 64 + lane]; const f32x2 bu = (f32x2){bflo(bw), bfhi(bw)};
                const float nxr = __builtin_fmaf(ar, xr, __builtin_fmaf(-ai, xi, bu.x)), nxi = __builtin_fmaf(ar, xi, __builtin_fmaf(ai, xr, bu.y)); xr = nxr; xi = nxi;
                *(LAS unsigned*)(XL + tt * 272 + 4 * lane) = pk2(xr, xi); }
            LDS_WAIT();
            f32x4 a = (f32x4){0.f, 0.f, 0.f, 0.f};
#pragma unroll
            for (int ks = 0; ks < 4; ++ks) a = __builtin_amdgcn_mfma_f32_16x16x32_bf16(cf[ks], *(const LAS bf16x8*)(XL + cq * 272 + 64 * ks + 16 * rq), a, 0, 0, 0);
            const u32x2 uw = __builtin_bit_cast(u32x2, ua);
            const float y0 = a[0] + dsk[0] * bflo(uw.x), y1 = a[1] + dsk[1] * bfhi(uw.x), y2 = a[2] + dsk[2] * bflo(uw.y), y3 = a[3] + dsk[3] * bfhi(uw.y);
            u32x2 zw; zw.x = pk2(gelu_tanh(y0), gelu_tanh(y1)); zw.y = pk2(gelu_tanh(y2), gelu_tanh(y3));
            *(u32x2*)(Z + off) = zw;
            LDS_WAIT();
            ua = ub; ub = ua_n;
        }
        if (q == 3) *(f32x2*)(ssm_out + ((size_t)(b * 128 + g) * 64 + lane) * 2) = (f32x2){xr, xi};
        __syncthreads();
    }
}
__device__ __forceinline__ void ssm_sample(const Ctx& c, const float* USS, const float* h0, bf16* ZS, const float* lam_re, const float* lam_im, const float* log_dt, const float* b_re, const float* b_im,
                                           const float* c_re, const float* c_im, const float* d_skip, float* ssm_out) {
    const int gw = c.vcu * NWAVES + c.wave, NGW = c.G * NWAVES, lane = c.lane;
    for (int it = gw; it < 1024; it += NGW) {
        const int b = it >> 7, g = it & 127;
        const float lr = fminf(lam_re[g * 64 + lane], -1e-4f), lim = lam_im[g * 64 + lane], dt = __expf(log_dt[g]);
        const float mag = __expf(lr * dt); float sn, cs_; sincos_rr(lim * dt, sn, cs_);
        const float ar = mag * cs_, ai = mag * sn;
        const float den = 1.0f / (lr * lr + lim * lim), nr = ar - 1.0f;
        const float cr = (nr * lr + ai * lim) * den, ci = (ai * lr - nr * lim) * den;
        float u[16]; float sr = 0.f, si = 0.f;
#pragma unroll
        for (int k = 0; k < 16; ++k) { u[k] = USS[(size_t)b * 2048 + 16 * g + k]; sr += b_re[(size_t)(g * 64 + lane) * 16 + k] * u[k]; si += b_im[(size_t)(g * 64 + lane) * 16 + k] * u[k]; }
        const f32x2 hv = *(const f32x2*)(h0 + ((size_t)(b * 128 + g) * 64 + lane) * 2);
        const float xr = ar * hv.x - ai * hv.y + (cr * sr - ci * si), xi = ar * hv.y + ai * hv.x + (cr * si + ci * sr);
        *(f32x2*)(ssm_out + ((size_t)(b * 128 + g) * 64 + lane) * 2) = (f32x2){xr, xi};
        float myz = 0.f;
#pragma unroll
        for (int k = 0; k < 16; ++k) { const float y = wave_sum(c_re[(size_t)(g * 16 + k) * 64 + lane] * xr - c_im[(size_t)(g * 16 + k) * 64 + lane] * xi) + d_skip[16 * g + k] * u[k];
            const float z = gelu_tanh(y); myz = (lane == k) ? z : myz; }
        if (lane < 16) { ZS[(size_t)b * 2048 + 16 * g + lane] = (bf16)(pk2(myz, 0.f) & 0xffffu); const_cast<float*>(USS)[(size_t)b * 2048 + 16 * g + lane] = 0.f; }
    }
}


#define DIS_ATTN(...) __VA_ARGS__
#define DIS_ATTNS(...) __VA_ARGS__
#define DIS_SSM(...) __VA_ARGS__
#define DIS_SSMS(...) __VA_ARGS__
#define DIS_CONV(...) __VA_ARGS__
#define DIS_G1(...) __VA_ARGS__
#define DIS_G2(...) __VA_ARGS__
#define DIS_G3(...) __VA_ARGS__
#define DIS_G4(...) __VA_ARGS__


#define ATTN_FN attn_prompt
#define SSM_FN ssm_prompt

#ifndef ABL_ATTN_P
#define ABL_ATTN_P 1.0f
#endif
#ifndef ABL_ATTN_S
#define ABL_ATTN_S 1.0f
#endif
#ifndef ABL_SSM_P
#define ABL_SSM_P 1.0f
#endif
#ifndef ABL_SSM_S
#define ABL_SSM_S 1.0f
#endif
#ifndef ABL_FFN_P
#define ABL_FFN_P 1.0f
#endif
#ifndef ABL_FFN_S
#define ABL_FFN_S 1.0f
#endif
#ifndef ABL_S_A0
#define ABL_S_A0 1.0f
#endif
#ifndef ABL_S_A1
#define ABL_S_A1 1.0f
#endif
#ifndef ABL_S_S0
#define ABL_S_S0 1.0f
#endif
#ifndef ABL_S_S1
#define ABL_S_S1 1.0f
#endif
#ifndef ABL_S_F0
#define ABL_S_F0 1.0f
#endif
#ifndef ABL_S_F1
#define ABL_S_F1 1.0f
#endif
#ifndef ABL_S_F2
#define ABL_S_F2 1.0f
#endif
#ifndef ABL_S_F3
#define ABL_S_F3 1.0f
#endif
#define GEMM_FN gemm_phase
#ifndef ABL_P_A0
#define ABL_P_A0 1.0f
#endif
#ifndef ABL_P_A1
#define ABL_P_A1 1.0f
#endif
#ifndef ABL_P_S0
#define ABL_P_S0 1.0f
#endif
#ifndef ABL_P_S1
#define ABL_P_S1 1.0f
#endif
#ifndef ABL_P_F0
#define ABL_P_F0 1.0f
#endif
#ifndef ABL_P_F1
#define ABL_P_F1 1.0f
#endif
#ifndef ABL_P_F2
#define ABL_P_F2 1.0f
#endif
#ifndef ABL_P_F3
#define ABL_P_F3 1.0f
#endif
#define QKV_GEMM_CALL DIS_G1(pg8::GEMM_FN<pg8::EpiQKV, pg8::StaticOrder, true, true>(c.lds, g, S, E));
#define QKV_POST(LI)
#define GLU_EPI pg8::EpiGLU E{WSP(bf16, WS_M)}; DIS_G4(pg8::GEMM_FN<pg8::EpiGLU, pg8::StaticOrder, true, true>(c.lds, g, S, E));
#define GLU_POSTNORM(LI) postnorm_rows<false, false, true>(c, MP, args.out + O_YP, args.out + O_YP, WSP(const float, WS_M), D, NG(2 * (LI) + 1, 1), NG(2 * (LI) + 1, 2), WSP(bf16, WS_H), ((LI) == 0 ? ABL_P_S0 : ABL_P_S1));
#define UPGEMM_CALL pg8::GEMM_FN<pg8::EpiConv, pg8::StaticOrder, true, true>(c.lds, g, S, E);
struct Args { const float* in[24]; float* out; unsigned char* ws; int ph_lo, ph_hi; };
enum { I_XP = 0, I_XS, I_CK0, I_CK1, I_CK2, I_SSSM, I_SCONV, I_NG, I_WQKV, I_WO, I_WIN, I_LRE, I_LIM, I_LDT, I_BRE, I_BIM, I_CRE, I_CIM, I_DSK, I_WGLU, I_WUP, I_CW, I_CB, I_WDN };
#define WSP(T, off) ((T*)(args.ws + (off)))
#define SMP(T, off) ((T*)(args.ws + WS_SMP + (off)))
#define NG(i, j) (args.in[I_NG] + (size_t)((i) * 4 + (j)) * D)

#define PH_ATTN_LAYER(LI, PB) \
    if (IN((PB) + 0)) {     \
        const bf16* Wqkv = WSP(const bf16, WS_WQKV + (LI) * WQKV_L); \
        { pg8::Gemm g{WSP(const bf16, WS_H), Wqkv, MP, NQKV, D}; pg8::StaticOrder S; S.init(MP, NQKV, c.G, (int)blockIdx.x); \
          pg8::EpiQKV E{WSP(bf16, WS_Q), WSP(bf16, WS_VT), WSP(const float, WS_CS), args.out, (LI), 0.08838834764831845f * 1.4426950408889634f}; \
          QKV_GEMM_CALL } \
        skinny_gemm(c, SMP(const bf16, SM_HS), Wqkv, NQKV, D, SMP(float, SM_QKV), 128); \
        CONVQ_TAIL((PB) + 0, 128, CQ_CAPQ); \
    } \
    SEAM((PB) + 0); \
    QKV_POST((LI)) \
    if (IN((PB) + 1)) {     \
        DIS_ATTN(ATTN_FN(c, WSP(const bf16, WS_Q), WSP(const bf16, WS_K), WSP(const bf16, WS_VT), WSP(bf16, WS_OG), WSP(float, WS_LSE), WSP(float, WS_LL))); \
        DIS_ATTNS(attn_sample<0>(c, (LI), SMP(const float, SM_QKV), WSP(const float, WS_CS), args.in[I_CK0], SMP(float, SM_OSG), SMP(float, SM_LSE), args.out + O_KV0S)); \
        DIS_ATTNS(attn_sample<1>(c, (LI), SMP(const float, SM_QKV), WSP(const float, WS_CS), args.in[I_CK1], SMP(float, SM_OSG), SMP(float, SM_LSE), args.out + O_KV1S)); \
        DIS_ATTNS(attn_sample<2>(c, (LI), SMP(const float, SM_QKV), WSP(const float, WS_CS), args.in[I_CK2], SMP(float, SM_OSG), SMP(float, SM_LSE), args.out + O_KV2S)); \
    } \
    SEAM((PB) + 1); \
    if (IN((PB) + 2)) { merge_prompt(c, WSP(const bf16, WS_OG), WSP(const float, WS_LSE), WSP(const float, WS_LL), WSP(bf16, WS_O)); merge_sample(c, SMP(const float, SM_OSG), SMP(const float, SM_LSE), SMP(bf16, SM_OS)); } \
    SEAM((PB) + 2); \
    if (IN((PB) + 3)) {     \
        const bf16* Wo = WSP(const bf16, WS_WO + (LI) * WO_L); \
        { pg8::Gemm g{WSP(const bf16, WS_O), Wo, MP, D, AW}; pg8::StaticOrder S; S.init(MP, D, c.G, (int)blockIdx.x); \
          pg8::EpiBf16 E{WSP(bf16, WS_M), D}; \
          pg8::GEMM_FN<pg8::EpiBf16, pg8::StaticOrder, true, true>(c.lds, g, S, E); } \
        skinny_gemm<4>(c, SMP(const bf16, SM_OS), Wo, D, AW, SMP(float, SM_MS)); \
    } \
    SEAM((PB) + 3); \
    if (IN((PB) + 4)) { \
        postnorm_rows<false, false, true>(c, MP, (LI) == 0 ? args.in[I_XP] : args.out + O_YP, args.out + O_YP, WSP(const float, WS_M), D, NG(2 * (LI), 1), NG(2 * (LI), 2), WSP(bf16, WS_H), ((LI) == 0 ? ABL_P_A0 : ABL_P_A1)); \
        postnorm_rows<false, true>(c, NS, (LI) == 0 ? args.in[I_XS] : args.out + O_YS, args.out + O_YS, SMP(const float, SM_MS), D, NG(2 * (LI), 1), NG(2 * (LI), 2), SMP(bf16, SM_HS), ((LI) == 0 ? ABL_S_A0 : ABL_S_A1)); \
    } \
    SEAM((PB) + 4);

#define PH_SSM_LAYER(LI, PB) \
    if (IN((PB) + 0)) {     \
        const bf16* Win = WSP(const bf16, WS_WIN + (LI) * WIN_L); \
        { pg8::Gemm g{WSP(const bf16, WS_H), Win, MP, D, D}; pg8::StaticOrder S; S.init(MP, D, c.G, (int)blockIdx.x); \
          pg8::EpiBf16 E{WSP(bf16, WS_USSM), D}; \
          DIS_G3(pg8::GEMM_FN<pg8::EpiBf16, pg8::StaticOrder, true, true>(c.lds, g, S, E)); } \
        skinny_gemm<4>(c, SMP(const bf16, SM_HS), Win, D, D, SMP(float, SM_USSM)); \
    } \
    SEAM((PB) + 0); \
    if (IN((PB) + 1)) { \
        const size_t o1 = (size_t)(LI) * 128 * 64, o2 = (size_t)(LI) * 128, o3 = (size_t)(LI) * 128 * 64 * 16, o4 = (size_t)(LI) * 2048; \
        DIS_SSM(SSM_FN(c, WSP(const bf16, WS_USSM), WSP(bf16, WS_Z), args.in[I_LRE] + o1, args.in[I_LIM] + o1, args.in[I_LDT] + o2, args.in[I_BRE] + o3, args.in[I_BIM] + o3, args.in[I_CRE] + o3, args.in[I_CIM] + o3, args.in[I_DSK] + o4, args.out + O_SSMP + (LI) * SSMP_L)); \
        DIS_SSMS(ssm_sample(c, SMP(const float, SM_USSM), args.in[I_SSSM] + (size_t)(LI) * SSMS_L, SMP(bf16, SM_ZS), args.in[I_LRE] + o1, args.in[I_LIM] + o1, args.in[I_LDT] + o2, args.in[I_BRE] + o3, args.in[I_BIM] + o3, args.in[I_CRE] + o3, args.in[I_CIM] + o3, args.in[I_DSK] + o4, args.out + O_SSMS + (LI) * SSMS_L)); \
    } \
    SEAM((PB) + 1); \
    if (IN((PB) + 2)) {     \
        const bf16* Wglu = WSP(const bf16, WS_WGLU + (LI) * WGLU_L); \
        { pg8::Gemm g{WSP(const bf16, WS_Z), Wglu, MP, GLU2, D}; pg8::StaticOrder S; S.init(MP, GLU2, c.G, (int)blockIdx.x); \
          GLU_EPI } \
        skinny_gemm(c, SMP(const bf16, SM_ZS), Wglu, GLU2, D, SMP(float, SM_MS)); \
    } \
    SEAM((PB) + 2); \
    if (IN((PB) + 3)) { \
        GLU_POSTNORM((LI)) \
        postnorm_rows<true, true>(c, NS, args.out + O_YS, args.out + O_YS, SMP(const float, SM_MS), GLU2, NG(2 * (LI) + 1, 1), NG(2 * (LI) + 1, 2), SMP(bf16, SM_HS), ((LI) == 0 ? ABL_S_S0 : ABL_S_S1)); \
    } \
    SEAM((PB) + 3);

#define PH_FFN(I, FB) \
    if (IN((FB) + 0)) {     \
        const bf16* Wup = WSP(const bf16, WS_WUP + (I) * WUP_L); \
        { pg8::Gemm g{WSP(const bf16, WS_H), Wup, MP, FF2, D}; pg8::StaticOrder S; S.init(MP, FF2, c.G, (int)blockIdx.x); \
          pg8::EpiConv E{WSP(bf16, WS_ACT), args.in[I_CW] + (size_t)(I) * 3 * FF2, args.in[I_CB] + (size_t)(I) * FF2, WSP(float, WS_U), WSP(float, WS_U) + 64 * FF2, args.out + O_CONVP + (I) * CONVP_L, (PG8_LAS float*)(c.lds + 132096)}; \
          UPGEMM_CALL } \
        skinny_gemm(c, SMP(const bf16, SM_HS), Wup, FF2, D, SMP(float, SM_US), 96); \
        CONVQ_TAIL((FB) + 0, 96, CQ_CAPU); \
    } \
    SEAM((FB) + 0); \
    if (IN((FB) + 1)) { \
        conv_fixup(c, WSP(const float, WS_U), WSP(const float, WS_U) + 64 * FF2, WSP(bf16, WS_ACT), args.in[I_CW] + (size_t)(I) * 3 * FF2); \
        conv_sample(c, SMP(const float, SM_US), args.in[I_SCONV] + (size_t)(I) * CONVS_L, SMP(bf16, SM_ACT), args.in[I_CW] + (size_t)(I) * 3 * FF2, args.in[I_CB] + (size_t)(I) * FF2, args.out + O_CONVS + (I) * CONVS_L); \
    } \
    SEAM((FB) + 1); \
    if (IN((FB) + 2)) {     \
        const bf16* Wdn = WSP(const bf16, WS_WDN + (I) * WDN_L); \
        { pg8::Gemm g{WSP(const bf16, WS_ACT), Wdn, MP, D, FF}; pg8::StaticOrder S; S.init(MP, D, c.G, (int)blockIdx.x); \
          pg8::EpiBf16 E{WSP(bf16, WS_M), D}; \
          pg8::GEMM_FN<pg8::EpiBf16, pg8::StaticOrder, true, true>(c.lds, g, S, E); } \
        skinny_gemm<4>(c, SMP(const bf16, SM_ACT), Wdn, D, FF, SMP(float, SM_MS)); \
    } \
    SEAM((FB) + 2); \
    if (IN((FB) + 3)) { \
        const float* g2 = ((I) < 3) ? NG((I) + 1, 0) : nullptr; \
        postnorm_rows<false, false, true>(c, MP, args.out + O_YP, args.out + O_YP, WSP(const float, WS_M), D, NG((I), 3), g2, WSP(bf16, WS_H), ((I) == 0 ? ABL_P_F0 : (I) == 1 ? ABL_P_F1 : (I) == 2 ? ABL_P_F2 : ABL_P_F3)); \
        postnorm_rows<false, true>(c, NS, args.out + O_YS, args.out + O_YS, SMP(const float, SM_MS), D, NG((I), 3), g2, SMP(bf16, SM_HS), ((I) == 0 ? ABL_S_F0 : (I) == 1 ? ABL_S_F1 : (I) == 2 ? ABL_S_F2 : ABL_S_F3)); \
    } \
    SEAM((FB) + 3);

__global__ void __launch_bounds__(NWAVES * 64, 2) fwd_kernel(Args args) {
    extern __shared__ __attribute__((aligned(16))) unsigned char lds_raw[];
    Ctx c; c.lds = (LAS unsigned char*)lds_raw; c.tid = threadIdx.x; c.lane = c.tid & 63; c.wave = __builtin_amdgcn_readfirstlane(c.tid >> 6);
    c.G = gridDim.x; { const int bx = blockIdx.x; c.vcu = (c.G % 8 == 0) ? (bx % 8) * (c.G / 8) + bx / 8 : bx; }
    volatile LAS unsigned* MISC = (volatile LAS unsigned*)(c.lds + MISC_OFF);
    if (c.tid < 32) MISC[c.tid] = 0u;
    __syncthreads();
    XcdBarrier bar = xcd_barrier_post((unsigned*)(args.ws + WS_CTL) + CW_BAR, MISC + 8);
    const int lo = args.ph_lo, hi = args.ph_hi;
#define IN(k) (lo <= (k) && (k) < hi)
#define DBG_STAMP(i) do { } while (0)
#define SEAM(k) do { CONVQ_SEAM(k); if (IN(k) && IN((k) + 1)) xcd_barrier(bar); DBG_STAMP((k) + 1); } while (0)
    DBG_STAMP(0);

    if (IN(0)) {
        CONVQ_RANGE(0, convq_need(1), c.vcu * NWAVES + c.wave, c.G * NWAVES, 0);
        build_cs(c, WSP(float, WS_CS));
        zero_f32(c, SMP(float, SM_QKV), 8 * NQKV); zero_f32(c, SMP(float, SM_MS), 8 * GLU2); zero_f32(c, SMP(float, SM_US), 8 * FF2); zero_f32(c, SMP(float, SM_USSM), 8 * D);
        prenorm_rows(c, MP, args.in[I_XP], args.in[I_NG], WSP(bf16, WS_H));
        prenorm_rows(c, NS, args.in[I_XS], args.in[I_NG], SMP(bf16, SM_HS));
    }
    SEAM(0);
    PH_ATTN_LAYER(0, 1)
    PH_FFN(0, 6)
    PH_SSM_LAYER(0, 10)
    PH_FFN(1, 14)
    PH_ATTN_LAYER(1, 18)
    PH_FFN(2, 23)
    PH_SSM_LAYER(1, 27)
    PH_FFN(3, 31)
#undef IN
#undef SEAM
}

#ifndef MK_PER_PHASE
#define MK_PER_PHASE 0
#endif
extern "C" void kernel_launch(void* const* d_in, const int* in_sizes, int n_in, void* d_out, int out_size, void* d_ws, size_t ws_size, hipStream_t stream) {
    static int grid = 0;
    if (grid == 0) {
        if (n_in != 24 || in_sizes[0] != MP * D || (size_t)out_size != O_END || ws_size < WS_END) {
            fprintf(stderr, "kernel_launch: shape mismatch: n_in %d in0 %d out %d ws %zu (need 24, %d, %zu, >= %zu); nothing launched\n", n_in, n_in > 0 ? in_sizes[0] : -1, out_size, ws_size, MP * D, (size_t)O_END, (size_t)WS_END); grid = -1; return; }
        { const long long exp_sz[24] = {(long long)MP * D, (long long)NS * D, 2LL * 8 * 128 * 2048, 2LL * 8 * 512 * 2048, 2LL * 8 * 2048 * 2048, 2LL * 8 * 128 * 64 * 2, 4LL * 8 * 2 * FF2, 4LL * 4 * D,
              2LL * D * NQKV, 2LL * AW * D, 2LL * D * D, 2LL * 128 * 64, 2LL * 128 * 64, 2LL * 128, 2LL * 128 * 64 * 16, 2LL * 128 * 64 * 16, 2LL * 128 * 16 * 64, 2LL * 128 * 16 * 64, 2LL * D, 2LL * D * GLU2,
              4LL * D * FF2, 4LL * 3 * FF2, 4LL * FF2, 4LL * FF * D};
          for (int i = 0; i < 24; ++i) if ((long long)in_sizes[i] != exp_sz[i]) { fprintf(stderr, "kernel_launch: input %d has %d elements, expected %lld; nothing launched\n", i, in_sizes[i], exp_sz[i]); grid = -1; return; } }
        int dev = 0, cus = 0, per_cu = 0;
        if (hipGetDevice(&dev) != hipSuccess || hipDeviceGetAttribute(&cus, hipDeviceAttributeMultiprocessorCount, dev) != hipSuccess) { fprintf(stderr, "kernel_launch: device query failed\n"); grid = -1; return; }
        if (hipFuncSetAttribute((const void*)fwd_kernel, hipFuncAttributeMaxDynamicSharedMemorySize, LDS_BYTES) != hipSuccess) { fprintf(stderr, "kernel_launch: hipFuncSetAttribute failed\n"); grid = -1; return; }
        if (hipOccupancyMaxActiveBlocksPerMultiprocessor(&per_cu, (const void*)fwd_kernel, NWAVES * 64, LDS_BYTES) != hipSuccess || per_cu < 1)
            fprintf(stderr, "kernel_launch: note: occupancy query reports %d workgroups per CU\n", per_cu);
        (void)hipGetLastError();
        grid = cus;
        if (grid != 256) { fprintf(stderr, "kernel_launch: %d CUs (built for 256); nothing launched\n", grid); grid = -1; return; }
    }
    if (grid < 0) return;
    if (hipMemsetAsync((char*)d_ws + WS_CTL, 0, CTL_ZERO_BYTES, stream) != hipSuccess) { fprintf(stderr, "kernel_launch: memset failed\n"); return; }
    Args a{};
    for (int i = 0; i < 24; ++i) a.in[i] = (const float*)d_in[i];
    a.out = (float*)d_out; a.ws = (unsigned char*)d_ws;
#if MK_PER_PHASE
    for (int p = 0; p < N_PHASES; ++p) { a.ph_lo = p; a.ph_hi = p + 1; hipLaunchKernelGGL(fwd_kernel, dim3(grid), dim3(NWAVES * 64), LDS_BYTES, stream, a); }
#else
    a.ph_lo = 0; a.ph_hi = N_PHASES;
    hipLaunchKernelGGL(fwd_kernel, dim3(grid), dim3(NWAVES * 64), LDS_BYTES, stream, a);
#endif
    const hipError_t le = hipPeekAtLastError();
    if (le != hipSuccess) fprintf(stderr, "kernel_launch: launch failed: %s\n", hipGetErrorName(le));
}
```

```cpp
#include <hip/hip_runtime.h>
#include <cstdio>
#include <cstdint>

constexpr int NWAVES = 8;
constexpr int NB = 4, T = 2048, D = 2048, MP = NB * T, NS = 8;
constexpr int NQKV = 9216, AW = 1024, FF = 5504, FF2 = 11008, GLU2 = 4096;
constexpr float RMS_EPS = 1e-6f;
constexpr int N_PHASES = 35;

constexpr size_t O_YP = 0;
constexpr size_t O_YS = O_YP + (size_t)MP * D;
constexpr size_t KV0P_L = (size_t)4 * 128 * 2048, KV1P_L = (size_t)4 * 512 * 2048, KV2P_L = (size_t)4 * 2048 * 2048, KVS_L = 8 * 2048;
constexpr size_t O_KV0P = O_YS + (size_t)NS * D;
constexpr size_t O_KV0S = O_KV0P + 2 * KV0P_L;
constexpr size_t O_KV1P = O_KV0S + 2 * KVS_L;
constexpr size_t O_KV1S = O_KV1P + 2 * KV1P_L;
constexpr size_t O_KV2P = O_KV1S + 2 * KVS_L;
constexpr size_t O_KV2S = O_KV2P + 2 * KV2P_L;
constexpr size_t O_SSMP = O_KV2S + 2 * KVS_L;
constexpr size_t SSMP_L = 4 * 128 * 64 * 2, SSMS_L = 8 * 128 * 64 * 2;
constexpr size_t O_SSMS = O_SSMP + 2 * SSMP_L;
constexpr size_t O_CONVP = O_SSMS + 2 * SSMS_L;
constexpr size_t CONVP_L = 4 * 2 * FF2, CONVS_L = 8 * 2 * FF2;
constexpr size_t O_CONVS = O_CONVP + 4 * CONVP_L;
constexpr size_t O_END = O_CONVS + 4 * CONVS_L;
static_assert(O_END == 62382080, "d_out layout");

namespace pg8 {
#define PG8_LAS __attribute__((address_space(3)))
typedef unsigned short bf16_t;
typedef short bf16x8 __attribute__((ext_vector_type(8)));
typedef float f32x4 __attribute__((ext_vector_type(4)));
typedef unsigned u32x4 __attribute__((ext_vector_type(4)));
constexpr int BM = 256, BK = 64, HALF = 128, HTB = HALF * BK * 2  , STAGE_BYTES = 8 * HTB, NXCD = 8, WGM = 8;

__host__ __device__ __forceinline__ int lds_byte(int r, int c) { const int st = (r >> 4) * 2 + (c >> 5), rr = r & 15, cc = c & 31, ob = rr * 64 + cc * 2; return st * 1024 + (ob ^ (((ob >> 9) & 1) << 5)); }
__host__ __device__ __forceinline__ void stage_rc(int b, int& R, int& C) { const int st = b / 1024, sb = b % 1024, swz = sb ^ (((sb >> 9) & 1) << 5); R = (st >> 1) * 16 + swz / 64; C = (st & 1) * 32 + (swz % 64) / 2; }
__host__ __device__ __forceinline__ int perm32(int rho) { const int n = rho >> 4, i = rho & 15; return 8 * (i >> 2) + 4 * n + (i & 3); }

struct Unit { int pm, pn; };
struct Gemm { const bf16_t* A; const bf16_t* Bt; int M, N, K; };

struct StaticOrder {
    int nM, nN, nwg, G, c;
    __host__ __device__ void init(int M, int N, int G_, int c_) { nM = M / BM; nN = N / BM; nwg = nM * nN; G = G_; c = c_; }
    __host__ __device__ bool next(int i, Unit& u) const {
        const long L = (long)i * G + c; if (L >= nwg) return false;
        int wgid = (int)L; { const int q = nwg / NXCD, r = nwg % NXCD, xcd = wgid % NXCD, off = wgid / NXCD; wgid = (xcd < r ? xcd * (q + 1) : r * (q + 1) + (xcd - r) * q) + off; }
        const int nig = WGM * nN, gid = wgid / nig, fm = gid * WGM, gsz = (nM - fm) < WGM ? (nM - fm) : WGM;
        u.pm = fm + ((wgid % nig) % gsz); u.pn = (wgid % nig) / gsz; return true;
    }
    __device__ __forceinline__ void a_ready(const Unit&) const {}
    __device__ __forceinline__ void done(const Unit&) const {}
};


__device__ __forceinline__ unsigned cvt_pk_bf16(float lo, float hi) { unsigned r; asm volatile("v_cvt_pk_bf16_f32 %0, %1, %2" : "=v"(r) : "v"(lo), "v"(hi)); return r; }
typedef unsigned u32x2 __attribute__((ext_vector_type(2)));

struct EpiF32 {
    static constexpr bool PERM = false, AFTER_DRAIN = false;
    float* C; int ldc;
    __device__ __forceinline__ void operator()(const f32x4 (&acc)[2][2][4][2], const Unit& u, int wr, int wc, int fr, int fq) const {
        const int row0 = u.pm * BM + wr * 64 + fr, col0 = u.pn * BM + wc * 32 + 4 * fq;
#pragma unroll
        for (int ai = 0; ai < 2; ++ai)
#pragma unroll
            for (int m = 0; m < 4; ++m) { float* rowp = C + (size_t)(row0 + ai * HALF + m * 16) * ldc + col0;
#pragma unroll
                for (int bj = 0; bj < 2; ++bj)
#pragma unroll
                    for (int n = 0; n < 2; ++n) *(f32x4*)(rowp + bj * HALF + n * 16) = acc[ai][bj][m][n]; }
    }
};
struct EpiBf16 {
    static constexpr bool PERM = true, AFTER_DRAIN = false;
    bf16_t* O; int ldc;
    __device__ __forceinline__ void operator()(const f32x4 (&acc)[2][2][4][2], const Unit& u, int wr, int wc, int fr, int fq) const {
        const int row0 = u.pm * BM + wr * 64 + fr, col0 = u.pn * BM + wc * 32 + 8 * fq;
#pragma unroll
        for (int ai = 0; ai < 2; ++ai)
#pragma unroll
            for (int m = 0; m < 4; ++m) { bf16_t* rowp = O + (size_t)(row0 + ai * HALF + m * 16) * ldc + col0;
#pragma unroll
                for (int bj = 0; bj < 2; ++bj) { const f32x4 v0 = acc[ai][bj][m][0], v1 = acc[ai][bj][m][1];
                    u32x4 w; w.x = cvt_pk_bf16(v0[0], v0[1]); w.y = cvt_pk_bf16(v0[2], v0[3]); w.z = cvt_pk_bf16(v1[0], v1[1]); w.w = cvt_pk_bf16(v1[2], v1[3]);
                    *(u32x4*)(rowp + bj * HALF) = w; } }
    }
};
struct EpiGLU {
    static constexpr bool PERM = true, AFTER_DRAIN = false;
    bf16_t* C;
    __device__ __forceinline__ void operator()(const f32x4 (&acc)[2][2][4][2], const Unit& u, int wr, int wc, int fr, int fq) const {
        const int row0 = u.pm * BM + wr * 64 + fr, col0 = u.pn * HALF + wc * 32 + 8 * fq;
#pragma unroll
        for (int ai = 0; ai < 2; ++ai)
#pragma unroll
            for (int m = 0; m < 4; ++m) { bf16_t* rowp = C + (size_t)(row0 + ai * HALF + m * 16) * 2048 + col0; u32x4 w;
#pragma unroll
                for (int n = 0; n < 2; ++n) { const f32x4 a = acc[ai][0][m][n], g = acc[ai][1][m][n]; f32x4 o;
#pragma unroll
                    for (int e = 0; e < 4; ++e) o[e] = a[e] * __builtin_amdgcn_rcpf(1.0f + __builtin_amdgcn_exp2f(-1.44269504089f * g[e]));
                    if (n == 0) { w.x = cvt_pk_bf16(o[0], o[1]); w.y = cvt_pk_bf16(o[2], o[3]); } else { w.z = cvt_pk_bf16(o[0], o[1]); w.w = cvt_pk_bf16(o[2], o[3]); } }
                *(u32x4*)rowp = w; }
    }
};
struct EpiQKV {
    static constexpr bool PERM = true, AFTER_DRAIN = false;
    bf16_t* Q; bf16_t* VT; const float* cs; float* out; int li; float qscale;
    __device__ __forceinline__ void operator()(const f32x4 (&acc)[2][2][4][2], const Unit& u, int wr, int wc, int fr, int fq) const {
        const int which = u.pn / 12, rem = u.pn - which * 12, g = rem >> 2, hp = rem & 3;
        const int dsh = 2 * g, S = 2048 >> dsh, keep = 128 << dsh;
        const size_t kvoff = g == 0 ? (O_KV0P + (size_t)li * KV0P_L) : (g == 1 ? (O_KV1P + (size_t)li * KV1P_L) : (O_KV2P + (size_t)li * KV2P_L));
        float* kvout = out + kvoff;
        const int d0 = wc * 32 + 8 * fq;
        const bool rot = (which < 2) && (wc == 0);
        const bool hi = fq >= 2;
#pragma unroll
        for (int ai = 0; ai < 2; ++ai)
#pragma unroll
            for (int m = 0; m < 4; ++m) {
                const int row = u.pm * BM + ai * HALF + wr * 64 + m * 16 + fr;
                const int b = row >> 11, t = row & 2047;
                const int idx = (t & ((1 << dsh) - 1)) * S + (t >> dsh);
                f32x4 c0 = (f32x4){1.f, 1.f, 1.f, 1.f}, c1 = c0, s0 = (f32x4){0.f, 0.f, 0.f, 0.f}, s1 = s0;
                if (rot) { const float* cp = cs + t * 32 + 8 * (fq & 1); c0 = *(const f32x4*)cp; c1 = *(const f32x4*)(cp + 4); s0 = *(const f32x4*)(cp + 16); s1 = *(const f32x4*)(cp + 20); }
#pragma unroll
                for (int bj = 0; bj < 2; ++bj) {
                    const int h = 2 * hp + bj, bgh = (b * 3 + g) * 8 + h;
                    f32x4 v0 = acc[ai][bj][m][0], v1 = acc[ai][bj][m][1];
                    if (rot) {
                        f32x4 p0, p1;
#pragma unroll
                        for (int e = 0; e < 4; ++e) { p0[e] = __shfl_xor(v0[e], 32); p1[e] = __shfl_xor(v1[e], 32); }
                        if (hi) { v0 = v0 * c0 + p0 * s0; v1 = v1 * c1 + p1 * s1; } else { v0 = v0 * c0 - p0 * s0; v1 = v1 * c1 - p1 * s1; }
                    }
                    if (which >= 1) { const int tt = t - (2048 - keep);
                        if (tt >= 0) { float* o = kvout + ((((size_t)b * keep + tt) * 2 + (which - 1)) * 8 + h) * 128 + d0; *(f32x4*)o = v0; *(f32x4*)(o + 4) = v1; } }
                    if (which == 0) { v0 = v0 * qscale; v1 = v1 * qscale; }
                    bf16_t* o = Q + (size_t)which * ((size_t)48 << 19) + ((size_t)bgh * 2048 + idx) * 128 + d0;
                    u32x4 w; w.x = cvt_pk_bf16(v0[0], v0[1]); w.y = cvt_pk_bf16(v0[2], v0[3]); w.z = cvt_pk_bf16(v1[0], v1[1]); w.w = cvt_pk_bf16(v1[2], v1[3]);
                    *(u32x4*)o = w;
                }
            }
    }
};
__device__ __forceinline__ float dpp_shr1(float cur, float prevgrp) {
    const int x = __builtin_amdgcn_update_dpp(0, __float_as_int(prevgrp), 0x121, 0xF, 0xF, false);
    return __int_as_float(__builtin_amdgcn_update_dpp(x, __float_as_int(cur), 0x111, 0xF, 0xF, false)); }
__device__ __forceinline__ float dpp_shr2(float cur, float prevgrp) {
    const int x = __builtin_amdgcn_update_dpp(0, __float_as_int(prevgrp), 0x122, 0xF, 0xF, false);
    return __int_as_float(__builtin_amdgcn_update_dpp(x, __float_as_int(cur), 0x112, 0xF, 0xF, false)); }
struct EpiConv {
    static constexpr bool PERM = true, AFTER_DRAIN = false;
    bf16_t* ACT; const float* cw; const float* cb; float* part; float* halou; float* convp; PG8_LAS float* halo;
    __device__ __forceinline__ void operator()(const f32x4 (&acc)[2][2][4][2], const Unit& u, int wr, int wc, int fr, int fq) const {
        constexpr int FFc = 5504, FF2c = 11008;
        if (fr >= 14) {
#pragma unroll
            for (int ai = 0; ai < 2; ++ai)
#pragma unroll
                for (int bj = 0; bj < 2; ++bj)
#pragma unroll
                    for (int n = 0; n < 2; ++n) *(PG8_LAS f32x4*)(halo + ((((ai * 2 + wr) * 4 + wc) * 2 + (fr - 14)) * 64 + bj * 32 + 8 * fq + 4 * n)) = acc[ai][bj][3][n];
            if (wr == 1) {
#pragma unroll
                for (int bj = 0; bj < 2; ++bj)
#pragma unroll
                    for (int n = 0; n < 2; ++n) { const int cs_ = bj * HALF + wc * 32 + 8 * fq + 4 * n;
                        *(f32x4*)(halou + ((size_t)u.pm * 2 + (fr - 14)) * FF2c + u.pn * BM + cs_) = acc[1][bj][3][n];
                        if ((u.pm & 7) == 7) *(f32x4*)(convp + ((size_t)(u.pm >> 3) * 2 + (fr - 14)) * FF2c + bj * FFc + u.pn * HALF + wc * 32 + 8 * fq + 4 * n) = acc[1][bj][3][n]; }
            }
        }
        asm volatile("s_waitcnt lgkmcnt(0)" ::: "memory"); __builtin_amdgcn_s_barrier(); asm volatile("" ::: "memory");
        const bool seq_start = (u.pm & 7) == 0;
        u32x2 keep[2][4];
#pragma unroll
        for (int n = 0; n < 2; ++n) {
            const int jg = u.pn * HALF + wc * 32 + 8 * fq + 4 * n;
            const f32x4 bg = *(const f32x4*)(cb + jg), bv = *(const f32x4*)(cb + FFc + jg);
            const f32x4 g0w = *(const f32x4*)(cw + jg), g1w = *(const f32x4*)(cw + FF2c + jg), g2w = *(const f32x4*)(cw + 2 * FF2c + jg);
            const f32x4 v0w = *(const f32x4*)(cw + FFc + jg), v1w = *(const f32x4*)(cw + FF2c + FFc + jg), v2w = *(const f32x4*)(cw + 2 * FF2c + FFc + jg);
#pragma unroll
            for (int ai = 0; ai < 2; ++ai)
#pragma unroll
                for (int m = 0; m < 4; ++m) {
                    const f32x4 cg = acc[ai][0][m][n], cv = acc[ai][1][m][n];
                    f32x4 pg = (f32x4){0.f, 0.f, 0.f, 0.f}, pv = (f32x4){0.f, 0.f, 0.f, 0.f};
                    if (m > 0) { pg = acc[ai][0][m - 1][n]; pv = acc[ai][1][m - 1][n]; }
                    else if (!(ai == 0 && wr == 0)) { const int pai = wr == 1 ? ai : ai - 1, pwr = wr == 1 ? 0 : 1;
                        if (fr >= 14) { const PG8_LAS float* hp = halo + ((((pai * 2 + pwr) * 4 + wc) * 2 + (fr - 14)) * 64 + 8 * fq + 4 * n); pg = *(const PG8_LAS f32x4*)hp; pv = *(const PG8_LAS f32x4*)(hp + 32); } }
                    f32x4 og, ov;
#pragma unroll
                    for (int e = 0; e < 4; ++e) {
                        const float g1 = dpp_shr1(cg[e], pg[e]), g2 = dpp_shr2(cg[e], pg[e]), v1 = dpp_shr1(cv[e], pv[e]), v2 = dpp_shr2(cv[e], pv[e]);
                        og[e] = bg[e] + g0w[e] * g2 + g1w[e] * g1 + g2w[e] * cg[e]; ov[e] = bv[e] + v0w[e] * v2 + v1w[e] * v1 + v2w[e] * cv[e]; }
                    const int row = u.pm * BM + ai * HALF + wr * 64 + m * 16 + fr;
                    const bool partial = (ai == 0 && wr == 0 && m == 0 && fr < 2 && !seq_start);
                    if (partial) { float* pp = part + ((size_t)u.pm * 2 + fr) * FF2c + u.pn * BM + wc * 32 + 8 * fq + 4 * n; *(f32x4*)pp = og; *(f32x4*)(pp + HALF) = ov; }
                    f32x4 a;
#pragma unroll
                    for (int e = 0; e < 4; ++e) a[e] = og[e] * __builtin_amdgcn_rcpf(1.0f + __builtin_amdgcn_exp2f(-1.44269504089f * og[e])) * ov[e];
                    u32x2 w; w.x = cvt_pk_bf16(a[0], a[1]); w.y = cvt_pk_bf16(a[2], a[3]);
                    if (n == 0) keep[ai][m] = w;
                    else if (!partial) { u32x4 w4; w4.x = keep[ai][m].x; w4.y = keep[ai][m].y; w4.z = w.x; w4.w = w.y; *(u32x4*)(ACT + (size_t)row * FFc + jg - 4) = w4; }
                }
        }
    }
};

template <class Epi, class Sched, bool ALIGN_EPI = false, bool SP2 = false>
__device__ __forceinline__ void gemm_phase(PG8_LAS unsigned char* lds, const Gemm g, const Sched& S, const Epi& E) {
    const int tid = threadIdx.x, wid = __builtin_amdgcn_readfirstlane(tid >> 6), lane = tid & 63, wr = wid >> 2, wc = wid & 3, fr = lane & 15, fq = lane >> 4;
    const int K = g.K, nt = K / BK;
    unsigned voffA[2], voffB[2];
#pragma unroll
    for (int i = 0; i < 2; ++i) { int R, C; stage_rc(tid * 16 + i * 8192, R, C); const int Rb = Epi::PERM ? ((R & ~31) + perm32(R & 31)) : R;
        voffA[i] = (unsigned)(R * K + C) * 2u; voffB[i] = (unsigned)(Rb * K + C) * 2u; }
    const size_t kstep = (size_t)(BK * 2);
    const size_t hstep = (size_t)HALF * K * 2;
    const size_t tstep = 2 * hstep;
    const unsigned ldsw = (unsigned)wid * 1024u;
    const int aoff = lds_byte(wr * 64 + fr, fq * 8), boff = lds_byte(wc * 32 + fr, fq * 8);
#define PG8_SA(b, h) (((b) * 2 + (h)) * HTB)
#define PG8_SB(b, h) ((4 + (b) * 2 + (h)) * HTB)
#define PG8_STAGE(bufoff, gbase, voff) do { _Pragma("unroll") for (int _i = 0; _i < 2; ++_i) \
        __builtin_amdgcn_global_load_lds((const unsigned*)((const char*)(gbase) + (voff)[_i]), (PG8_LAS unsigned*)(lds + (bufoff) + ldsw + _i * 8192), 16, 0, 0); } while (0)
#define PG8_LDA(dst, b, h) do { _Pragma("unroll") for (int m = 0; m < 4; ++m) _Pragma("unroll") for (int k = 0; k < 2; ++k) dst[m][k] = *(const PG8_LAS bf16x8*)(lds + PG8_SA(b, h) + aoff + m * 2048 + k * 1024); } while (0)
#define PG8_LDB(dst, b, h) do { _Pragma("unroll") for (int n = 0; n < 2; ++n) _Pragma("unroll") for (int k = 0; k < 2; ++k) dst[n][k] = *(const PG8_LAS bf16x8*)(lds + PG8_SB(b, h) + boff + n * 2048 + k * 1024); } while (0)
#define PG8_MMA(ai, bj, At, Bt) do { __builtin_amdgcn_s_setprio(1); _Pragma("unroll") for (int m = 0; m < 4; ++m) _Pragma("unroll") for (int n = 0; n < 2; ++n) _Pragma("unroll") for (int k = 0; k < 2; ++k) \
        acc[ai][bj][m][n] = __builtin_amdgcn_mfma_f32_16x16x32_bf16(Bt[n][k], At[m][k], acc[ai][bj][m][n], 0, 0, 0); __builtin_amdgcn_s_setprio(0); } while (0)
#define PG8_WAIT_V(n) asm volatile("s_waitcnt vmcnt(" #n ")" ::: "memory")
#define PG8_WAIT_L(n) asm volatile("s_waitcnt lgkmcnt(" #n ")" ::: "memory")
#define PG8_BAR __builtin_amdgcn_s_barrier()
#define PG8_SCHED __builtin_amdgcn_sched_barrier(0)
    Unit cur, nxt; int ui = 0;
    if (!S.next(0, cur)) return;
    f32x4 acc[2][2][4][2];
#pragma unroll
    for (int a = 0; a < 2; ++a)
#pragma unroll
        for (int b = 0; b < 2; ++b)
#pragma unroll
            for (int m = 0; m < 4; ++m)
#pragma unroll
                for (int n = 0; n < 2; ++n) acc[a][b][m][n] = (f32x4){0.f, 0.f, 0.f, 0.f};
    bf16x8 At[4][2], B0[2][2], B1[2][2];
    const char* cA = (const char*)g.A + (size_t)cur.pm * tstep; const char* cB = (const char*)g.Bt + (size_t)cur.pn * tstep;
    S.a_ready(cur);
    if constexpr (SP2) {
        PG8_STAGE(PG8_SB(0, 0), cB, voffB); PG8_STAGE(PG8_SB(0, 1), cB + hstep, voffB); PG8_STAGE(PG8_SA(0, 0), cA, voffA); PG8_STAGE(PG8_SA(0, 1), cA + hstep, voffA);
        if (wr == 1) PG8_BAR;
        PG8_WAIT_V(2); PG8_BAR;
        PG8_STAGE(PG8_SB(1, 0), cB + kstep, voffB); PG8_STAGE(PG8_SA(1, 0), cA + kstep, voffA); PG8_STAGE(PG8_SB(1, 1), cB + hstep + kstep, voffB);
        PG8_WAIT_V(6); PG8_BAR;
    } else {
        PG8_STAGE(PG8_SB(0, 0), cB, voffB); PG8_STAGE(PG8_SA(0, 0), cA, voffA); PG8_STAGE(PG8_SB(0, 1), cB + hstep, voffB); PG8_STAGE(PG8_SA(0, 1), cA + hstep, voffA);
        if (wr == 1) PG8_BAR;
        PG8_WAIT_V(4); PG8_BAR;
        PG8_STAGE(PG8_SB(1, 0), cB + kstep, voffB); PG8_STAGE(PG8_SA(1, 0), cA + kstep, voffA); PG8_STAGE(PG8_SB(1, 1), cB + hstep + kstep, voffB);
        PG8_WAIT_V(6); PG8_BAR;
    }
    for (;;) {
        const bool has_next = S.next(ui + 1, nxt);
        const char* nA = has_next ? (const char*)g.A + (size_t)nxt.pm * tstep : cA; const char* nB = has_next ? (const char*)g.Bt + (size_t)nxt.pn * tstep : cB;
        for (int t = 0; t < nt; t += 2) {
            const bool last = (t == nt - 2);
            const char* a1 = cA + (size_t)(t + 1) * kstep;
            const char* a2 = last ? nA : cA + (size_t)(t + 2) * kstep; const char* b2 = last ? nB : cB + (size_t)(t + 2) * kstep;
            const char* a3 = a2 + kstep; const char* b3 = b2 + kstep;
            if (last && has_next) S.a_ready(nxt);
            if constexpr (SP2) {
            PG8_LDB(B0, 0, 0); PG8_LDB(B1, 0, 1); PG8_SCHED; PG8_LDA(At, 0, 0); PG8_STAGE(PG8_SA(1, 1), a1 + hstep, voffA);
            PG8_WAIT_V(8); PG8_WAIT_L(0); PG8_BAR; PG8_MMA(0, 0, At, B0); PG8_MMA(0, 1, At, B1); PG8_BAR; PG8_SCHED;
            PG8_LDA(At, 0, 1); PG8_STAGE(PG8_SB(0, 0), b2, voffB); PG8_STAGE(PG8_SB(0, 1), b2 + hstep, voffB); PG8_STAGE(PG8_SA(0, 0), a2, voffA);
            PG8_WAIT_V(8); PG8_WAIT_L(0); PG8_BAR; PG8_MMA(1, 0, At, B0); PG8_MMA(1, 1, At, B1); PG8_BAR; PG8_SCHED;
            PG8_LDB(B0, 1, 0); PG8_LDB(B1, 1, 1); PG8_SCHED; PG8_LDA(At, 1, 0); PG8_STAGE(PG8_SA(0, 1), a2 + hstep, voffA);
            PG8_WAIT_V(8); PG8_WAIT_L(0); PG8_BAR; PG8_MMA(0, 0, At, B0); PG8_MMA(0, 1, At, B1); PG8_BAR; PG8_SCHED;
            PG8_LDA(At, 1, 1); PG8_STAGE(PG8_SB(1, 0), b3, voffB); PG8_STAGE(PG8_SB(1, 1), b3 + hstep, voffB); PG8_STAGE(PG8_SA(1, 0), a3, voffA);
            PG8_WAIT_V(8); PG8_WAIT_L(0); PG8_BAR; PG8_MMA(1, 0, At, B0); PG8_MMA(1, 1, At, B1); PG8_BAR; PG8_SCHED;
            } else {
            PG8_LDB(B0, 0, 0); PG8_SCHED; PG8_LDA(At, 0, 0); PG8_STAGE(PG8_SA(1, 1), a1 + hstep, voffA);
            PG8_WAIT_L(8); PG8_BAR; PG8_WAIT_L(0); PG8_MMA(0, 0, At, B0); PG8_BAR; PG8_SCHED;
            PG8_LDB(B1, 0, 1); PG8_STAGE(PG8_SB(0, 0), b2, voffB);
            PG8_BAR; PG8_WAIT_L(0); PG8_MMA(0, 1, At, B1); PG8_BAR;
            PG8_LDA(At, 0, 1); PG8_STAGE(PG8_SA(0, 0), a2, voffA);
            PG8_BAR; PG8_WAIT_L(0); PG8_MMA(1, 0, At, B0); PG8_BAR; PG8_SCHED;
            PG8_STAGE(PG8_SB(0, 1), b2 + hstep, voffB);
            PG8_WAIT_V(6); PG8_BAR; PG8_MMA(1, 1, At, B1); PG8_BAR;
            PG8_LDB(B0, 1, 0); PG8_SCHED; PG8_LDA(At, 1, 0); PG8_STAGE(PG8_SA(0, 1), a2 + hstep, voffA);
            PG8_WAIT_L(8); PG8_BAR; PG8_WAIT_L(0); PG8_MMA(0, 0, At, B0); PG8_BAR; PG8_SCHED;
            PG8_LDB(B1, 1, 1); PG8_STAGE(PG8_SB(1, 0), b3, voffB);
            PG8_BAR; PG8_WAIT_L(0); PG8_MMA(0, 1, At, B1); PG8_BAR;
            PG8_LDA(At, 1, 1); PG8_STAGE(PG8_SA(1, 0), a3, voffA);
            PG8_BAR; PG8_WAIT_L(0); PG8_MMA(1, 0, At, B0); PG8_BAR; PG8_SCHED;
            PG8_STAGE(PG8_SB(1, 1), b3 + hstep, voffB);
            PG8_WAIT_V(6); PG8_BAR; PG8_MMA(1, 1, At, B1); PG8_BAR;
            }
        }
        if constexpr (ALIGN_EPI) { if (wr == 0) PG8_BAR; }
        if constexpr (!Epi::AFTER_DRAIN) { E(acc, cur, wr, wc, fr, fq); S.done(cur); }
        if (!has_next) break;
#pragma unroll
        for (int a = 0; a < 2; ++a)
#pragma unroll
            for (int b = 0; b < 2; ++b)
#pragma unroll
                for (int m = 0; m < 4; ++m)
#pragma unroll
                    for (int n = 0; n < 2; ++n) acc[a][b][m][n] = (f32x4){0.f, 0.f, 0.f, 0.f};
        cur = nxt; cA = nA; cB = nB; ++ui;
        if constexpr (ALIGN_EPI) { if (wr == 1) PG8_BAR; }
    }
    PG8_WAIT_V(0);
    if constexpr (!ALIGN_EPI) { if (wr == 0) PG8_BAR; }
    PG8_BAR;
    if constexpr (Epi::AFTER_DRAIN) { E.fused(acc, cur, wr, wc, fr, fq, lds, wid, lane); S.done(cur); }
#undef PG8_SA
#undef PG8_SB
#undef PG8_STAGE
#undef PG8_LDA
#undef PG8_LDB
#undef PG8_MMA
#undef PG8_WAIT_V
#undef PG8_WAIT_L
#undef PG8_BAR
#undef PG8_SCHED
}

}

constexpr size_t MiB = 1u << 20;
constexpr size_t WS_CTL = 0, CTL_ZERO_BYTES = 1 * MiB;
constexpr size_t WS_CS = 1 * MiB;
constexpr size_t WS_SMP = 2 * MiB;
constexpr size_t WS_WQKV = 4 * MiB,  WQKV_L = (size_t)NQKV * D * 2;
constexpr size_t WS_WO = 76 * MiB,   WO_L = (size_t)D * AW * 2;
constexpr size_t WS_WIN = 84 * MiB,  WIN_L = (size_t)D * D * 2;
constexpr size_t WS_WGLU = 100 * MiB, WGLU_L = (size_t)GLU2 * D * 2;
constexpr size_t WS_WUP = 132 * MiB, WUP_L = (size_t)FF2 * D * 2;
constexpr size_t WS_WDN = 304 * MiB, WDN_L = (size_t)D * FF * 2;
constexpr size_t WS_H = 390 * MiB;
constexpr size_t WS_Q = 422 * MiB, WS_K = 470 * MiB, WS_VT = 518 * MiB;
constexpr size_t WS_OG = 566 * MiB;
constexpr size_t WS_LSE = 614 * MiB;
constexpr size_t WS_O = 615 * MiB;
constexpr size_t WS_M = 631 * MiB;
constexpr size_t WS_U = 695 * MiB;
constexpr size_t WS_ACT = 867 * MiB;
constexpr size_t WS_USSM = 953 * MiB;
constexpr size_t WS_Z = 985 * MiB;
constexpr size_t WS_LL = 1017 * MiB;
constexpr size_t WS_END = 1018 * MiB;
static_assert(WS_WQKV + 2 * WQKV_L <= WS_WO && WS_WO + 2 * WO_L <= WS_WIN && WS_WIN + 2 * WIN_L <= WS_WGLU && WS_WGLU + 2 * WGLU_L <= WS_WUP && WS_WUP + 4 * WUP_L <= WS_WDN && WS_WDN + 4 * WDN_L <= WS_H, "ws map (weights)");
static_assert(WS_U + (size_t)MP * FF2 * 2 <= WS_ACT && WS_ACT + (size_t)MP * FF * 2 <= WS_USSM, "ws map (acts)");
constexpr size_t SM_HS = 0;
constexpr size_t SM_QKV = 64 * 1024;
constexpr size_t SM_OSG = 384 * 1024;
constexpr size_t SM_LSE = 512 * 1024;
constexpr size_t SM_OS = 528 * 1024;
constexpr size_t SM_MS = 576 * 1024;
constexpr size_t SM_US = 704 * 1024;
constexpr size_t SM_ACT = 1088 * 1024;
constexpr size_t SM_ZS = 1216 * 1024;
constexpr size_t SM_USSM = 1280 * 1024;
constexpr int CW_BAR = 4096;
constexpr int CW_CONVQ = 12288;

constexpr int RING_BYTES = 131072;
constexpr int LDS_BYTES = 163840;
constexpr int MISC_OFF = LDS_BYTES - 256;

#ifndef CONV_TAILS
#define CONV_TAILS 1
#endif
#ifndef CONV_NQ
#define CONV_NQ 8
#endif
#ifndef CONV_NU
#define CONV_NU 7
#endif
#ifndef CONV_KT
#define CONV_KT 64
#endif
#define LAS __attribute__((address_space(3)))
typedef unsigned short bf16;
typedef float f32x4 __attribute__((ext_vector_type(4)));
typedef float f32x2 __attribute__((ext_vector_type(2)));
typedef short bf16x8 __attribute__((ext_vector_type(8)));
typedef short bf16x4 __attribute__((ext_vector_type(4)));
typedef unsigned u32x4 __attribute__((ext_vector_type(4)));
typedef unsigned u32x2 __attribute__((ext_vector_type(2)));
#define LDS_WAIT() asm volatile("s_waitcnt lgkmcnt(0)" ::: "memory")
__device__ __forceinline__ unsigned pk2(float lo, float hi) { return pg8::cvt_pk_bf16(lo, hi); }
typedef __bf16 bf16v2 __attribute__((ext_vector_type(2)));
__device__ __forceinline__ unsigned pk2v(float lo, float hi) { return __builtin_bit_cast(unsigned, __builtin_convertvector((f32x2){lo, hi}, bf16v2)); }
__device__ __forceinline__ float bf2f(unsigned short b) { return __uint_as_float(((unsigned)b) << 16); }
__device__ __forceinline__ float bflo(unsigned w) { return __uint_as_float(w << 16); }
__device__ __forceinline__ float bfhi(unsigned w) { return __uint_as_float(w & 0xffff0000u); }
__device__ __forceinline__ float wave_sum(float v) {
#pragma unroll
    for (int o = 1; o < 64; o <<= 1) v += __shfl_xor(v, o);
    return v;
}
__device__ __forceinline__ float sigmoidf_(float x) { return __builtin_amdgcn_rcpf(1.0f + __builtin_amdgcn_exp2f(-1.44269504089f * x)); }
__device__ __forceinline__ float gelu_tanh(float y) { const float z = 0.7978845608028654f * (y + 0.044715f * y * y * y); return y * sigmoidf_(2.0f * z); }
__device__ __forceinline__ void sincos_rr(float ang, float& s, float& c) {
    const double x = (double)ang, kd = rint(x * 0.63661977236758134308), r = fma(-kd, 1.57079632679489661923, x) - kd * 6.123233995736766e-17, r2 = r * r;
    double sp = 1.0 / 6227020800.0; sp = sp * r2 - 1.0 / 39916800.0; sp = sp * r2 + 1.0 / 362880.0; sp = sp * r2 - 1.0 / 5040.0; sp = sp * r2 + 1.0 / 120.0; sp = sp * r2 - 1.0 / 6.0; sp = sp * r2 * r + r;
    double cp = -1.0 / 87178291200.0; cp = cp * r2 + 1.0 / 479001600.0; cp = cp * r2 - 1.0 / 3628800.0; cp = cp * r2 + 1.0 / 40320.0; cp = cp * r2 - 1.0 / 720.0; cp = cp * r2 + 1.0 / 24.0; cp = cp * r2 - 0.5; cp = cp * r2 + 1.0;
    const int q = (int)((long long)kd & 3);
    const double ss = (q & 1) ? cp : sp, cc = (q & 1) ? sp : cp;
    s = (float)((q & 2) ? -ss : ss); c = (float)(((q + 1) & 2) ? -cc : cc);
}
#define XB_TMO      128
#define XB_XCNT(j)  (256  + 64 * (j))
#define XB_XSUB(j)  (1280 + 64 * (j))
#define XB_XGEN(j)  (2304 + 64 * (j))
#define XB_TOP      3328
#define XB_TOPGEN   3392
#define XCD_BAR_WORDS 3456
#define XB_SPIN_CAP (1u << 18)

__device__ __forceinline__ unsigned xb_ld(unsigned* p)              { return __hip_atomic_load(p, __ATOMIC_RELAXED, __HIP_MEMORY_SCOPE_AGENT); }
__device__ __forceinline__ unsigned xb_add(unsigned* p, unsigned v) { return __hip_atomic_fetch_add(p, v, __ATOMIC_RELAXED, __HIP_MEMORY_SCOPE_AGENT); }
__device__ __forceinline__ unsigned xb_xcc_id() { return (unsigned)__builtin_amdgcn_s_getreg((3 << 11) | 20) & 0xFu; }
#define XB_SPIN(cond, bar) do { unsigned _sp = 0; while (cond) { __builtin_amdgcn_s_sleep(1); \
    if ((++_sp & 255u) == 0u) { if (xb_ld(&(bar)[XB_TMO])) break; if (_sp > XB_SPIN_CAP) { atomicAdd(&(bar)[XB_TMO], 1u); break; } } } } while (0)

struct XcdBarrier {
    unsigned* bar; unsigned x;
    volatile LAS unsigned* st;
};

__device__ __forceinline__ XcdBarrier xcd_barrier_post(unsigned* bar, volatile LAS unsigned* st) {
    XcdBarrier b; b.bar = bar; b.x = xb_xcc_id(); b.st = st;
    if (threadIdx.x == 0) (void)xb_add(&bar[XB_XCNT(b.x)], 1u);
    return b;
}
__device__ __forceinline__ void xcd_barrier_complete(unsigned* bar, unsigned x, unsigned& nloc, unsigned& nx) {
    const unsigned G = gridDim.x * gridDim.y * gridDim.z;
    unsigned sum, cnt, mine, sp = 0u;
    for (;;) {
        sum = 0u; cnt = 0u; mine = 0u;
#pragma unroll
        for (unsigned j = 0; j < 16; ++j) { const unsigned c = xb_ld(&bar[XB_XCNT(j)]); sum += c; cnt += (c > 0u) ? 1u : 0u; mine = (j == x) ? c : mine; }
        if (sum == G) break;
        __builtin_amdgcn_s_sleep(1);
        if ((++sp & 255u) == 0u) { if (xb_ld(&bar[XB_TMO])) break; if (sp > XB_SPIN_CAP) { atomicAdd(&bar[XB_TMO], 1u); break; } }
    }
    nloc = mine > 0u ? mine : 1u; nx = cnt > 0u ? cnt : 1u;
}

__device__ __forceinline__ void xcd_barrier(const XcdBarrier& b) {
    asm volatile("s_waitcnt vmcnt(0)" ::: "memory");
    __syncthreads();
    if (threadIdx.x == 0) {
        unsigned* bar = b.bar;
        __builtin_amdgcn_s_waitcnt(0);
        unsigned nloc = b.st[0], nx = b.st[1];
        if (nloc == 0u) { xcd_barrier_complete(bar, b.x, nloc, nx); b.st[0] = nloc; b.st[1] = nx; }
        const unsigned old = xb_add(&bar[XB_XSUB(b.x)], 1u);
        const unsigned gen = old / nloc;
        if (old + 1u == (gen + 1u) * nloc) {
            __builtin_amdgcn_fence(__ATOMIC_RELEASE, "agent");
            asm volatile("s_waitcnt vmcnt(0)" ::: "memory");
            const unsigned og = xb_add(&bar[XB_TOP], 1u);
            const unsigned tg = og / nx;
            if (og + 1u == (tg + 1u) * nx) xb_add(&bar[XB_TOPGEN], 1u);
            else XB_SPIN(xb_ld(&bar[XB_TOPGEN]) == tg, bar);
            __builtin_amdgcn_fence(__ATOMIC_ACQUIRE, "agent");
            xb_add(&bar[XB_XGEN(b.x)], 1u);
            asm volatile("s_waitcnt vmcnt(0)" ::: "memory");
        } else {
            XB_SPIN(xb_ld(&bar[XB_XGEN(b.x)]) == gen, bar);
            __builtin_amdgcn_fence(__ATOMIC_ACQUIRE, "agent");
            asm volatile("s_waitcnt vmcnt(0)" ::: "memory");
        }
    }
    __syncthreads();
}

struct Ctx { LAS unsigned char* lds; int tid, lane, wave, vcu, G; };

__device__ __forceinline__ void convert_item(const float* W, int K, int N, int IL, bf16* WT, int it, LAS float* scr, int lane) {
    const int nblk = N / 32, kb = it / nblk, nb = it - kb * nblk, n0 = 32 * nb, k0 = 64 * kb;
    int drow0 = n0;
    if (IL > 0) { const int isv = n0 >= IL ? 1 : 0, j = n0 - isv * IL; drow0 = (j >> 7) * 256 + isv * 128 + (j & 127); }
    const float* src = W + (size_t)(k0 + (lane >> 5)) * N + n0 + (lane & 31);
    float v[32];
#pragma unroll
    for (int i = 0; i < 32; ++i) v[i] = src[(size_t)(2 * i) * N];
#pragma unroll
    for (int i = 0; i < 32; ++i) scr[(2 * i + (lane >> 5)) * 33 + (lane & 31)] = v[i];
    LDS_WAIT(); asm volatile("" ::: "memory");
    const int cc = lane & 7;
#pragma unroll
    for (int j = 0; j < 4; ++j) { const int n = (lane >> 3) + 8 * j; const LAS float* s = scr + (8 * cc) * 33 + n;
        u32x4 o; o.x = pk2(s[0 * 33], s[1 * 33]); o.y = pk2(s[2 * 33], s[3 * 33]); o.z = pk2(s[4 * 33], s[5 * 33]); o.w = pk2(s[6 * 33], s[7 * 33]);
        *(u32x4*)(WT + (size_t)(drow0 + n) * K + k0 + 8 * cc) = o; }
    LDS_WAIT(); asm volatile("" ::: "memory");
}
constexpr int CQ_QKV = 9216, CQ_O = 1024, CQ_UP = 11008, CQ_DN = 5504, CQ_IN = 2048, CQ_GLU = 4096;
constexpr int CQ_L = CQ_QKV + CQ_O + CQ_UP + CQ_DN + CQ_IN + CQ_GLU + CQ_UP + CQ_DN;
constexpr int CQ_TOTAL = 2 * CQ_L;
__host__ __device__ constexpr int convq_need(int p) {
    if (p <= 0) return 0; if (p >= N_PHASES) return CQ_TOTAL;
    const int li = (p - 1) / 17, q = (p - 1) % 17;
    int n = li * CQ_L + CQ_QKV; if (q >= 1) n += 0;
    if (q >= 3) n += CQ_O; if (q >= 5) n += CQ_UP; if (q >= 7) n += CQ_DN; if (q >= 9) n += CQ_IN; if (q >= 11) n += CQ_GLU; if (q >= 13) n += CQ_UP; if (q >= 15) n += CQ_DN;
    if (q == 16 && li == 0) n += 0;
    return n;
}
__device__ __forceinline__ void convq_process(LAS unsigned char* lds, int wave, int lane, int it, const float* wqkv, const float* wo, const float* win, const float* wglu, const float* wup, const float* wdn, unsigned char* ws) {
    LAS float* scr = (LAS float*)(lds + wave * 17408);
    const int li = it >= CQ_L ? 1 : 0; int r = it - li * CQ_L;
    const float* W; bf16* WT; int K, N, IL = 0;
    if (r < CQ_QKV) { W = wqkv + (size_t)li * D * NQKV; K = D; N = NQKV; WT = (bf16*)(ws + WS_WQKV + li * WQKV_L); }
    else if ((r -= CQ_QKV) < CQ_O) { W = wo + (size_t)li * AW * D; K = AW; N = D; WT = (bf16*)(ws + WS_WO + li * WO_L); }
    else if ((r -= CQ_O) < CQ_UP) { W = wup + (size_t)(2 * li) * D * FF2; K = D; N = FF2; IL = FF; WT = (bf16*)(ws + WS_WUP + (2 * li) * WUP_L); }
    else if ((r -= CQ_UP) < CQ_DN) { W = wdn + (size_t)(2 * li) * FF * D; K = FF; N = D; WT = (bf16*)(ws + WS_WDN + (2 * li) * WDN_L); }
    else if ((r -= CQ_DN) < CQ_IN) { W = win + (size_t)li * D * D; K = D; N = D; WT = (bf16*)(ws + WS_WIN + li * WIN_L); }
    else if ((r -= CQ_IN) < CQ_GLU) { W = wglu + (size_t)li * D * GLU2; K = D; N = GLU2; IL = 2048; WT = (bf16*)(ws + WS_WGLU + li * WGLU_L); }
    else if ((r -= CQ_GLU) < CQ_UP) { W = wup + (size_t)(2 * li + 1) * D * FF2; K = D; N = FF2; IL = FF; WT = (bf16*)(ws + WS_WUP + (2 * li + 1) * WUP_L); }
    else { r -= CQ_UP; W = wdn + (size_t)(2 * li + 1) * FF * D; K = FF; N = D; WT = (bf16*)(ws + WS_WDN + (2 * li + 1) * WDN_L); }
    convert_item(W, K, N, IL, WT, r, scr, lane);
}
constexpr int CQ_CAPQ = 128 * 8 * CONV_NQ, CQ_CAPU = 160 * 8 * CONV_NU;
__host__ __device__ constexpr bool cq_is_q(int p) { return p >= 1 && ((p - 1) % 17) == 0; }
__host__ __device__ constexpr bool cq_is_u(int p) { return p >= 1 && (((p - 1) % 17) == 5 || ((p - 1) % 17) == 13); }
__host__ __device__ constexpr int cq_min(int a, int b) { return a < b ? a : b; }
__host__ __device__ constexpr int cq_max(int a, int b) { return a > b ? a : b; }
__host__ __device__ constexpr int cq_frontier(int p, int what) {
    int F = convq_need(1);
    for (int k = 1; k <= p; ++k) {
        if (k == p && what == 0) return F;
        if (cq_is_q(k)) F = cq_min(F + CQ_CAPQ, CQ_TOTAL); else if (cq_is_u(k)) F = cq_min(F + CQ_CAPU, CQ_TOTAL);
        if (k == p) return F;
        F = cq_max(F, convq_need(k + 1));
    }
    return F;
}
__device__ __noinline__ void convq_range(LAS unsigned char* lds, int lo, int hi, int rank, int stride, int sync, const float* wqkv, const float* wo, const float* win, const float* wglu, const float* wup, const float* wdn, unsigned char* ws) {
    if (sync) __syncthreads();
    const int lane = threadIdx.x & 63, wave = __builtin_amdgcn_readfirstlane(threadIdx.x >> 6);
    for (int it = lo + rank; it < hi; it += stride) convq_process(lds, wave, lane, it, wqkv, wo, win, wglu, wup, wdn, ws);
}
#define CONVQ_RANGE(lo, hi, rank, stride, sync) convq_range(c.lds, (lo), (hi), (rank), (stride), (sync), args.in[I_WQKV], args.in[I_WO], args.in[I_WIN], args.in[I_WGLU], args.in[I_WUP], args.in[I_WDN], args.ws)
#define CONVQ_SEAM(k) do { constexpr int lo_ = cq_frontier((k), 1), hi_ = convq_need((k) + 1); if (lo_ < hi_) CONVQ_RANGE(lo_, hi_, c.vcu * NWAVES + c.wave, c.G * NWAVES, 1); } while (0)
#define CONVQ_TAIL(p, nbusy, cap) do { constexpr int lo_ = cq_frontier((p), 0), hi_ = cq_min(lo_ + (cap), CQ_TOTAL); \
    if (CONV_TAILS && lo_ < hi_ && (int)blockIdx.x >= (nbusy)) CONVQ_RANGE(lo_, hi_, ((int)blockIdx.x - (nbusy)) * NWAVES + c.wave, ((int)gridDim.x - (nbusy)) * NWAVES, 0); } while (0)
__device__ __forceinline__ void build_cs(const Ctx& c, float* cs) {
    const int gt = (c.vcu * NWAVES + c.wave) * 64 + c.lane, NT = c.G * NWAVES * 64;
    for (int idx = gt; idx < 2049 * 16; idx += NT) {
        const int t = idx >> 4, i = idx & 15;
        const float pos = (t < 2048) ? (float)t : 16384.0f;
        const float inv = __builtin_amdgcn_exp2f(-18.931568569324174f * (float)i * 0.0625f);
        float s, co; sincos_rr(pos * inv, s, co);
        cs[t * 32 + i] = co; cs[t * 32 + 16 + i] = s;
    }
}
__device__ __forceinline__ void prenorm_rows(const Ctx& c, int nrows, const float* x, const float* g, bf16* H) {
    const int gw = c.vcu * NWAVES + c.wave, NGW = c.G * NWAVES;
    if (gw >= nrows) return;
    f32x4 gv[8], xn[8];
#pragma unroll
    for (int j = 0; j < 8; ++j) { gv[j] = *(const f32x4*)(g + 4 * c.lane + 256 * j); xn[j] = *(const f32x4*)(x + (size_t)gw * D + 4 * c.lane + 256 * j); }
    for (int row = gw; row < nrows; row += NGW) {
        f32x4 v[8]; float ss = 0.f;
#pragma unroll
        for (int j = 0; j < 8; ++j) { v[j] = xn[j]; ss += (v[j].x * v[j].x + v[j].y * v[j].y) + (v[j].z * v[j].z + v[j].w * v[j].w); }
        if (row + NGW < nrows) {
#pragma unroll
            for (int j = 0; j < 8; ++j) xn[j] = *(const f32x4*)(x + (size_t)(row + NGW) * D + 4 * c.lane + 256 * j); }
        const float rstd = 1.0f / sqrtf(wave_sum(ss) * (1.0f / D) + RMS_EPS);
#pragma unroll
        for (int j = 0; j < 8; ++j) { const f32x4 h = v[j] * rstd * gv[j];
            u32x2 w; w.x = pk2(h.x, h.y); w.y = pk2(h.z, h.w); *(u32x2*)(H + (size_t)row * D + 4 * c.lane + 256 * j) = w; }
    }
}
template <bool GLU, bool ZERO_M = false, bool MBF = false> __device__ __forceinline__ void postnorm_rows(const Ctx& c, int nrows, const float* xin, float* xout, const float* M, int ldm, const float* g1, const float* g2, bf16* H, float mscale = 1.0f) {
    const int gw = c.vcu * NWAVES + c.wave, NGW = c.G * NWAVES;
    if (gw >= nrows) return;
    f32x4 ga[8], gb[8];
#pragma unroll
    for (int j = 0; j < 8; ++j) { const int col = 4 * c.lane + 256 * j; ga[j] = *(const f32x4*)(g1 + col); gb[j] = g2 ? *(const f32x4*)(g2 + col) : (f32x4){0.f, 0.f, 0.f, 0.f}; }
    f32x4 v[8], xv[8]; u32x2 mw[8];
    auto load_row = [&](int row) {
        const float* mr = M + (size_t)row * ldm;
#pragma unroll
        for (int j = 0; j < 8; ++j) { const int col = 4 * c.lane + 256 * j;
            if (MBF) mw[j] = *(const u32x2*)((const bf16*)M + (size_t)row * ldm + col);
            else if (!GLU) { v[j] = *(const f32x4*)(mr + col); if (ZERO_M) *(f32x4*)const_cast<float*>(mr + col) = (f32x4){0.f, 0.f, 0.f, 0.f}; }
            else { const float* pa = mr + (col >> 7) * 256 + (col & 127); const f32x4 a = *(const f32x4*)pa, gt = *(const f32x4*)(pa + 128);
                if (ZERO_M) { *(f32x4*)const_cast<float*>(pa) = (f32x4){0.f, 0.f, 0.f, 0.f}; *(f32x4*)const_cast<float*>(pa + 128) = (f32x4){0.f, 0.f, 0.f, 0.f}; }
                v[j].x = a.x * sigmoidf_(gt.x); v[j].y = a.y * sigmoidf_(gt.y); v[j].z = a.z * sigmoidf_(gt.z); v[j].w = a.w * sigmoidf_(gt.w); }
            xv[j] = *(const f32x4*)(xin + (size_t)row * D + col); }
    };
    load_row(gw);
    for (int row = gw; row < nrows; row += NGW) {
        f32x4 xc[8]; u32x2 mc[8]; float ss = 0.f;
#pragma unroll
        for (int j = 0; j < 8; ++j) { if (MBF) mc[j] = mw[j]; else xc[j] = v[j];
            const f32x4 y = MBF ? (f32x4){bflo(mc[j].x), bfhi(mc[j].x), bflo(mc[j].y), bfhi(mc[j].y)} : xc[j];
            ss += (y.x * y.x + y.y * y.y) + (y.z * y.z + y.w * y.w); }
        f32x4 xo[8];
#pragma unroll
        for (int j = 0; j < 8; ++j) xo[j] = xv[j];
        if (MBF && row + NGW < nrows) load_row(row + NGW);
        const float rstd = 1.0f / sqrtf(wave_sum(ss) * (1.0f / D) + RMS_EPS);
        float ss2 = 0.f;
#pragma unroll
        for (int j = 0; j < 8; ++j) { const int col = 4 * c.lane + 256 * j;
            const f32x4 y = MBF ? (f32x4){bflo(mc[j].x), bfhi(mc[j].x), bflo(mc[j].y), bfhi(mc[j].y)} : xc[j];
            const f32x4 xn = xo[j] + y * (rstd * mscale) * ga[j]; *(f32x4*)(xout + (size_t)row * D + col) = xn; xo[j] = xn;
            ss2 += (xn.x * xn.x + xn.y * xn.y) + (xn.z * xn.z + xn.w * xn.w); }
        if (g2) {
            const float rstd2 = 1.0f / sqrtf(wave_sum(ss2) * (1.0f / D) + RMS_EPS);
#pragma unroll
            for (int j = 0; j < 8; ++j) { const int col = 4 * c.lane + 256 * j; const f32x4 h = xo[j] * rstd2 * gb[j];
                u32x2 w; w.x = pk2(h.x, h.y); w.y = pk2(h.z, h.w); *(u32x2*)(H + (size_t)row * D + col) = w; }
        }
    }
}


__device__ __forceinline__ void skinny_gemm(const Ctx& c, const bf16* A, const bf16* Bt, int N, int K, float* out, int first_wg = 0) {
    const int nks = K / 32, ncg = N / 16;
    const int cq = c.lane & 15, rq = c.lane >> 4;
    if ((int)blockIdx.x < first_wg) return;
    const int nw = c.G - first_wg, me = first_wg ? (int)blockIdx.x - first_wg : c.vcu;
    for (int it = c.wave * nw + me; it < ncg * 8; it += nw * NWAVES) {
        const int cg = it >> 3, kp = it & 7, ks0 = (kp * nks) >> 3, ks1 = ((kp + 1) * nks) >> 3;
        const bf16* bp = Bt + (size_t)(16 * cg + cq) * K + 8 * rq; const bf16* ap = A + (size_t)(cq & 7) * K + 8 * rq;
        f32x4 acc = (f32x4){0.f, 0.f, 0.f, 0.f};
#pragma unroll 4
        for (int ks = ks0; ks < ks1; ++ks) acc = __builtin_amdgcn_mfma_f32_16x16x32_bf16(*(const bf16x8*)(bp + 32 * ks), *(const bf16x8*)(ap + 32 * ks), acc, 0, 0, 0);
        if (cq < 8) { float* o = out + (size_t)cq * N + 16 * cg + 4 * rq;
#pragma unroll
            for (int e = 0; e < 4; ++e) unsafeAtomicAdd(o + e, acc[e]); }
    }
}
__device__ __forceinline__ void zero_f32(const Ctx& c, float* p, int n) {
    const int gt = (c.vcu * NWAVES + c.wave) * 64 + c.lane, NT = c.G * NWAVES * 64;
    for (int i = gt; i < n; i += NT) p[i] = 0.f;
}

constexpr int AT_KP = 272, AT_VP = 528, AT_VOFF = 256 * AT_KP;
struct AttnItem { int g, dsh, r, qt, bgh, base, row0; };
__device__ __forceinline__ AttnItem attn_item(int it) {
    AttnItem a; const int bh = it / 48, rem = it - bh * 48, sub = rem & 15, b = bh >> 3, h = bh & 7;
    a.g = rem >> 4; a.dsh = 2 * a.g; a.r = sub >> (4 - a.dsh); a.qt = sub & ((16 >> a.dsh) - 1);
    a.bgh = (b * 3 + a.g) * 8 + h; a.base = a.r * (2048 >> a.dsh); a.row0 = b * 2048; return a;
}
__device__ __forceinline__ void attn_stage_load(const AttnItem& a, const bf16* K, const bf16* V, int tid, u32x4 (&kr)[8], u32x4 (&vr)[8]) {
    const bf16* Kp = K + (size_t)a.bgh * 2048 * 128; const bf16* Vp = V + (size_t)a.bgh * 2048 * 128;
    const int kw0 = 128 * a.qt - 128, c16 = tid & 15, o = tid >> 4;
#pragma unroll
    for (int i = 0; i < 8; ++i) { int ks = kw0 + 32 * i + o; ks = ks < 0 ? 0 : ks;
        kr[i] = *(const u32x4*)(Kp + (size_t)(a.base + ks) * 128 + 8 * c16);
        int kv = kw0 + 8 * o + i; kv = kv < 0 ? 0 : kv;
        vr[i] = *(const u32x4*)(Vp + (size_t)(a.base + kv) * 128 + 8 * c16); }
}
__device__ __forceinline__ void attn_stage_store(LAS unsigned char* lds, int tid, const u32x4 (&kr)[8], const u32x4 (&vr)[8]) {
    const int c16 = tid & 15, o = tid >> 4;
#pragma unroll
    for (int i = 0; i < 8; ++i) *(LAS u32x4*)(lds + (32 * i + o) * AT_KP + 16 * c16) = kr[i];
#pragma unroll
    for (int e = 0; e < 8; ++e) { const unsigned sel = (e & 1) ? 0x07060302u : 0x05040100u; u32x4 w;
#pragma unroll
        for (int m = 0; m < 4; ++m) w[m] = __builtin_amdgcn_perm(vr[2 * m + 1][e >> 1], vr[2 * m][e >> 1], sel);
        *(LAS u32x4*)(lds + AT_VOFF + (8 * c16 + e) * AT_VP + 16 * (o ^ (c16 & 7))) = w; }
}
__device__ __forceinline__ void attn_prompt(const Ctx& c, const bf16* Q, const bf16* K, const bf16* VT, bf16* OG, float* LSE, float* LL) {
    const int cq = c.lane & 15, rq = c.lane >> 4, w = c.wave;
    u32x4 kr[8], vr[8]; bf16x8 qn[4];
    int it = c.vcu;
    if (it < 1536) { const AttnItem a0 = attn_item(it); attn_stage_load(a0, K, VT, c.tid, kr, vr);
#pragma unroll
        for (int ks = 0; ks < 4; ++ks) qn[ks] = *(const bf16x8*)(Q + ((size_t)a0.bgh * 2048 + a0.base + 128 * a0.qt + 16 * w + cq) * 128 + 32 * ks + 8 * rq); }
    for (; it < 1536; it += c.G) {
        const AttnItem a = attn_item(it);
        attn_stage_store(c.lds, c.tid, kr, vr);
        bf16x8 qf[4];
#pragma unroll
        for (int ks = 0; ks < 4; ++ks) qf[ks] = qn[ks];
        __syncthreads();
        if (it + c.G < 1536) { const AttnItem an = attn_item(it + c.G); attn_stage_load(an, K, VT, c.tid, kr, vr);
#pragma unroll
            for (int ks = 0; ks < 4; ++ks) qn[ks] = *(const bf16x8*)(Q + ((size_t)an.bgh * 2048 + an.base + 128 * an.qt + 16 * w + cq) * 128 + 32 * ks + 8 * rq); }
        const int dsh = a.dsh, g = a.g;
        const int s0 = 128 * a.qt + 16 * w, kb = s0 - 128;
        f32x4 st[9];
#pragma unroll
        for (int j = 0; j < 9; ++j) {
            const int krow = 16 * w + (j < 8 ? 32 * (j >> 1) + 8 * (cq >> 2) + 4 * (j & 1) + (cq & 3) : 128 + cq);
            const LAS unsigned char* kl = c.lds + krow * AT_KP + 16 * rq;
            f32x4 acc = (f32x4){0.f, 0.f, 0.f, 0.f};
#pragma unroll
            for (int ks = 0; ks < 4; ++ks) acc = __builtin_amdgcn_mfma_f32_16x16x32_bf16(*(const LAS bf16x8*)(kl + 64 * ks), qf[ks], acc, 0, 0, 0);
            st[j] = acc;
        }
        const int qs = s0 + cq, lo = (qs - 128) < 0 ? 0 : (qs - 128);
        float mx = -1e30f;
#pragma unroll
        for (int j = 0; j < 9; ++j)
#pragma unroll
            for (int e = 0; e < 4; ++e) { const int ksub = kb + (j < 8 ? 32 * (j >> 1) + 8 * rq + 4 * (j & 1) + e : 128 + 4 * rq + e); const bool ok = (ksub >= lo) && (ksub <= qs);
                const float v = ok ? st[j][e] : -1e30f; st[j][e] = v; mx = fmaxf(mx, v); }
        mx = fmaxf(mx, __shfl_xor(mx, 16)); mx = fmaxf(mx, __shfl_xor(mx, 32));
        float l = 0.f;
#pragma unroll
        for (int j = 0; j < 9; ++j)
#pragma unroll
            for (int e = 0; e < 4; ++e) { const float pv = __builtin_amdgcn_exp2f(st[j][e] - mx); st[j][e] = pv; l += pv; }
        l += __shfl_xor(l, 16); l += __shfl_xor(l, 32);
        bf16x8 pf[4];
#pragma unroll
        for (int p = 0; p < 4; ++p) { u32x4 wv; wv.x = pk2(st[2 * p][0], st[2 * p][1]); wv.y = pk2(st[2 * p][2], st[2 * p][3]); wv.z = pk2(st[2 * p + 1][0], st[2 * p + 1][1]); wv.w = pk2(st[2 * p + 1][2], st[2 * p + 1][3]);
            pf[p] = __builtin_bit_cast(bf16x8, wv); }
        u32x2 w8; w8.x = pk2(st[8][0], st[8][1]); w8.y = pk2(st[8][2], st[8][3]);
        const bf16x4 pf8 = __builtin_bit_cast(bf16x4, w8);
        const float rl = 1.0f / l;
        const int row = a.row0 + ((s0 + cq) << dsh) + a.r, h = a.bgh & 7;
        bf16* orow = OG + ((size_t)g * MP + row) * AW + h * 128 + 4 * rq;
#pragma unroll
        for (int i = 0; i < 8; ++i) {
            f32x4 acc = (f32x4){0.f, 0.f, 0.f, 0.f};
            const LAS unsigned char* vl = c.lds + AT_VOFF + (16 * i + cq) * AT_VP; const int swz = (2 * i + (cq >> 3)) & 7;
#pragma unroll
            for (int p = 0; p < 4; ++p) acc = __builtin_amdgcn_mfma_f32_16x16x32_bf16(*(const LAS bf16x8*)(vl + 16 * ((2 * w + 4 * p + rq) ^ swz)), pf[p], acc, 0, 0, 0);
            acc = __builtin_amdgcn_mfma_f32_16x16x16bf16_1k(*(const LAS bf16x4*)(vl + 16 * ((2 * w + 16 + (rq >> 1)) ^ swz) + 8 * (rq & 1)), pf8, acc, 0, 0, 0);
            u32x2 wv; wv.x = pk2(acc[0] * rl, acc[1] * rl); wv.y = pk2(acc[2] * rl, acc[3] * rl);
            *(u32x2*)(orow + 16 * i) = wv;
        }
        if (rq == 0) { LSE[((size_t)g * MP + row) * 8 + h] = (mx + __builtin_amdgcn_logf(l)) * 0.6931471805599453f; LL[((size_t)g * MP + row) * 8 + h] = l; }
        __syncthreads();
    }
}
__device__ __forceinline__ void merge_prompt(const Ctx& c, const bf16* OG, const float* LSE, const float* LL, bf16* O) {
    const int gw = c.vcu * NWAVES + c.wave, NGW = c.G * NWAVES, head = c.lane >> 3;
    u32x4 og[3][2]; float ls[3], lh[3], lz[3];
    auto load_row = [&](int row) {
#pragma unroll
        for (int gi = 0; gi < 3; ++gi) { const size_t i = ((size_t)gi * MP + row) * 8; ls[gi] = LSE[i + head]; lh[gi] = LL[i + head]; lz[gi] = LL[i];
#pragma unroll
            for (int hf = 0; hf < 2; ++hf) og[gi][hf] = *(const u32x4*)(OG + ((size_t)gi * MP + row) * AW + 16 * c.lane + 8 * hf); }
    };
    if (gw < MP) load_row(gw);
    for (int row = gw; row < MP; row += NGW) {
        u32x4 a[2], bq[2], cc[2];
#pragma unroll
        for (int hf = 0; hf < 2; ++hf) { a[hf] = og[0][hf]; bq[hf] = og[1][hf]; cc[hf] = og[2][hf]; }
        const float l0 = ls[0], l1 = ls[1], l2 = ls[2];
        const float m = fmaxf(l0, fmaxf(l1, l2)); float w0 = __expf(l0 - m), w1 = __expf(l1 - m), w2 = __expf(l2 - m); const float inv = 1.0f / (w0 + w1 + w2);
        w0 *= inv * lh[0] / lz[0]; w1 *= inv * lh[1] / lz[1]; w2 *= inv * lh[2] / lz[2];
        if (row + NGW < MP) load_row(row + NGW);
#pragma unroll
        for (int hf = 0; hf < 2; ++hf) { const int col = 16 * c.lane + 8 * hf;
            u32x4 o;
#pragma unroll
            for (int e = 0; e < 4; ++e) { const float lo = w0 * bflo(a[hf][e]) + w1 * bflo(bq[hf][e]) + w2 * bflo(cc[hf][e]), hi = w0 * bfhi(a[hf][e]) + w1 * bfhi(bq[hf][e]) + w2 * bfhi(cc[hf][e]); o[e] = pk2(lo, hi); }
            *(u32x4*)(O + (size_t)row * AW + col) = o; }
    }
}

template <int GG> __device__ __forceinline__ void attn_sample(const Ctx& c, int li, const float* QKVS, const float* cs, const float* ck, float* OSG, float* LSES, float* kvsb) {
    LAS float* sh = (LAS float*)c.lds;
    const float* csr = cs + 2048 * 32;
    constexpr int g = GG, dil = 1 << (2 * GG), L = 128 << (2 * GG);
    for (int it = c.vcu - 64 * GG; it >= 0 && it < 64; it += c.G) {
        const int b = it >> 3, h = it & 7;
        const float* cache = ck + ((size_t)(li * 8 + b) * L) * 2048;
        float* kvs = kvsb + (size_t)(li * 8 + b) * 2048;
        const float* qrow = QKVS + (size_t)b * NQKV + g * 1024 + h * 128;
        if (c.tid < 128) { const int d = c.tid;
            float qv = qrow[d], kv = qrow[3072 + d]; const float vv = qrow[6144 + d];
            if (d < 16) { const float co = csr[d], si = csr[16 + d]; const float q2 = qrow[d + 16], k2 = qrow[3072 + d + 16]; qv = qv * co - q2 * si; kv = kv * co - k2 * si; }
            else if (d < 32) { const float co = csr[d - 16], si = csr[d]; const float q1 = qrow[d - 16], k1 = qrow[3072 + d - 16]; qv = qv * co + q1 * si; kv = kv * co + k1 * si; }
            sh[d] = qv * 0.08838834764831845f; sh[128 + d] = kv; sh[256 + d] = vv;
            kvs[h * 128 + d] = kv; kvs[1024 + h * 128 + d] = vv; }
        __syncthreads();
        if (c.tid < 128) { float* qz = const_cast<float*>(qrow); qz[c.tid] = 0.f; qz[3072 + c.tid] = 0.f; qz[6144 + c.tid] = 0.f; }
        const f32x2 q2 = *(const LAS f32x2*)(sh + 2 * c.lane);
        float m = -1e30f, l = 0.f; f32x2 acc = (f32x2){0.f, 0.f};
        f32x2 kk[17], vv[17];
#pragma unroll
        for (int t = 0; t < 17; ++t) { const int jj = c.wave + 8 * t;
            if (jj == 0) { kk[t] = *(const LAS f32x2*)(sh + 128 + 2 * c.lane); vv[t] = *(const LAS f32x2*)(sh + 256 + 2 * c.lane); }
            else { const int jc = jj <= 128 ? jj : 128; const float* rp = cache + (size_t)(L - dil * jc) * 2048 + h * 128 + 2 * c.lane; kk[t] = *(const f32x2*)rp; vv[t] = *(const f32x2*)(rp + 1024); } }
        float sc_[17];
#pragma unroll
        for (int t = 0; t < 17; ++t) sc_[t] = q2.x * kk[t].x + q2.y * kk[t].y;
#pragma unroll
        for (int o = 1; o < 64; o <<= 1)
#pragma unroll
            for (int t = 0; t < 17; ++t) sc_[t] += __shfl_xor(sc_[t], o);
#pragma unroll
        for (int t = 0; t < 17; ++t) { const int jj = c.wave + 8 * t;
            if (jj <= 128) {
                const float s = sc_[t];
                const float mn = fmaxf(m, s), sc = __expf(m - mn), pe = __expf(s - mn);
                l = l * sc + pe; acc = acc * sc + vv[t] * pe; m = mn; } }
        LAS float* pw = sh + 512 + c.wave * 132;
        if (c.lane == 0) { pw[0] = m; pw[1] = l; }
        *(LAS f32x2*)(pw + 4 + 2 * c.lane) = acc;
        __syncthreads();
        if (c.wave == 0) {
            float M = -1e30f;
#pragma unroll
            for (int w = 0; w < 8; ++w) M = fmaxf(M, sh[512 + w * 132]);
            float Lt = 0.f; f32x2 o = (f32x2){0.f, 0.f};
#pragma unroll
            for (int w = 0; w < 8; ++w) { const float f = __expf(sh[512 + w * 132] - M); Lt += sh[512 + w * 132 + 1] * f; o += *(const LAS f32x2*)(sh + 512 + w * 132 + 4 + 2 * c.lane) * f; }
            const float rl = 1.0f / Lt;
            *(f32x2*)(OSG + ((size_t)g * 8 + b) * 1024 + h * 128 + 2 * c.lane) = o * rl;
            if (c.lane == 0) { LSES[(g * 8 + b) * 8 + h] = M + __logf(Lt); LSES[256 + (g * 8 + b) * 8 + h] = Lt; }
        }
        __syncthreads();
    }
}
__device__ __forceinline__ void merge_sample(const Ctx& c, const float* OSG, const float* LSES, bf16* OS) {
    if (c.vcu != 0) return;
    const int b = c.wave, head = c.lane >> 3;
    const float l0 = LSES[(0 * 8 + b) * 8 + head], l1 = LSES[(1 * 8 + b) * 8 + head], l2 = LSES[(2 * 8 + b) * 8 + head];
    const float m = fmaxf(l0, fmaxf(l1, l2)); float w0 = __expf(l0 - m), w1 = __expf(l1 - m), w2 = __expf(l2 - m); const float inv = 1.0f / (w0 + w1 + w2);
    w0 *= inv * LSES[256 + (0 * 8 + b) * 8 + head] / LSES[256 + (0 * 8 + b) * 8]; w1 *= inv * LSES[256 + (1 * 8 + b) * 8 + head] / LSES[256 + (1 * 8 + b) * 8]; w2 *= inv * LSES[256 + (2 * 8 + b) * 8 + head] / LSES[256 + (2 * 8 + b) * 8];
    f32x4 og[3][4];
#pragma unroll
    for (int gi = 0; gi < 3; ++gi)
#pragma unroll
        for (int k = 0; k < 4; ++k) og[gi][k] = *(const f32x4*)(OSG + (gi * 8 + b) * 1024 + 16 * c.lane + 4 * k);
#pragma unroll
    for (int hf = 0; hf < 2; ++hf) { u32x4 o;
#pragma unroll
        for (int k = 0; k < 2; ++k) { const f32x4 r = og[0][2 * hf + k] * w0 + og[1][2 * hf + k] * w1 + og[2][2 * hf + k] * w2;
            if (k == 0) { o.x = pk2(r.x, r.y); o.y = pk2(r.z, r.w); } else { o.z = pk2(r.x, r.y); o.w = pk2(r.z, r.w); } }
        *(u32x4*)(OS + (size_t)b * 1024 + 16 * c.lane + 8 * hf) = o; }
}

__device__ __forceinline__ void conv_prompt(const Ctx& c, const bf16* U, bf16* ACT, const float* cw, const float* cb, float* convp) {
    const int gw = c.vcu * NWAVES + c.wave, NGW = c.G * NWAVES, cl = c.lane & 15, rg = c.lane >> 4;
    for (int it = gw; it < 128 * 43; it += NGW) {
        const int rb = it / 43, pn = it - rb * 43;
        const int gcol = 128 * pn + 8 * cl, vcol = FF + gcol;
        float wg[3][8], wv[3][8], bg[8], bv[8];
#pragma unroll
        for (int e = 0; e < 8; ++e) { bg[e] = cb[gcol + e]; bv[e] = cb[vcol + e];
#pragma unroll
            for (int j = 0; j < 3; ++j) { wg[j][e] = cw[j * FF2 + gcol + e]; wv[j][e] = cw[j * FF2 + vcol + e]; } }
        const int row0 = rb * 64 + rg * 16;
        float g1[8], g2[8], v1[8], v2[8];
#pragma unroll
        for (int e = 0; e < 8; ++e) { g1[e] = 0.f; g2[e] = 0.f; v1[e] = 0.f; v2[e] = 0.f; }
        if ((row0 & 2047) != 0) {
            const u32x4 a1 = *(const u32x4*)(U + (size_t)(row0 - 1) * FF2 + 256 * pn + 8 * cl), b1 = *(const u32x4*)(U + (size_t)(row0 - 1) * FF2 + 256 * pn + 128 + 8 * cl);
            const u32x4 a2 = *(const u32x4*)(U + (size_t)(row0 - 2) * FF2 + 256 * pn + 8 * cl), b2 = *(const u32x4*)(U + (size_t)(row0 - 2) * FF2 + 256 * pn + 128 + 8 * cl);
#pragma unroll
            for (int e = 0; e < 4; ++e) { g1[2 * e] = bflo(a1[e]); g1[2 * e + 1] = bfhi(a1[e]); v1[2 * e] = bflo(b1[e]); v1[2 * e + 1] = bfhi(b1[e]);
                g2[2 * e] = bflo(a2[e]); g2[2 * e + 1] = bfhi(a2[e]); v2[2 * e] = bflo(b2[e]); v2[2 * e + 1] = bfhi(b2[e]); }
        }
        for (int rr = 0; rr < 16; ++rr) {
            const int row = row0 + rr;
            const u32x4 a0 = *(const u32x4*)(U + (size_t)row * FF2 + 256 * pn + 8 * cl), b0 = *(const u32x4*)(U + (size_t)row * FF2 + 256 * pn + 128 + 8 * cl);
            float g0[8], v0[8], act[8];
#pragma unroll
            for (int e = 0; e < 4; ++e) { g0[2 * e] = bflo(a0[e]); g0[2 * e + 1] = bfhi(a0[e]); v0[2 * e] = bflo(b0[e]); v0[2 * e + 1] = bfhi(b0[e]); }
#pragma unroll
            for (int e = 0; e < 8; ++e) { const float cg = bg[e] + wg[0][e] * g2[e] + wg[1][e] * g1[e] + wg[2][e] * g0[e], cv = bv[e] + wv[0][e] * v2[e] + wv[1][e] * v1[e] + wv[2][e] * v0[e];
                act[e] = cg * sigmoidf_(cg) * cv; g2[e] = g1[e]; g1[e] = g0[e]; v2[e] = v1[e]; v1[e] = v0[e]; }
            u32x4 o; o.x = pk2(act[0], act[1]); o.y = pk2(act[2], act[3]); o.z = pk2(act[4], act[5]); o.w = pk2(act[6], act[7]);
            *(u32x4*)(ACT + (size_t)row * FF + gcol) = o;
            const int t = row & 2047;
            if (t >= 2046) { float* o1 = convp + ((size_t)(row >> 11) * 2 + (t - 2046)) * FF2;
#pragma unroll
                for (int e = 0; e < 8; ++e) { o1[gcol + e] = g0[e]; o1[vcol + e] = v0[e]; } }
        }
    }
}
__device__ __forceinline__ void conv_sample(const Ctx& c, const float* US, const float* st, bf16* ACTS, const float* cw, const float* cb, float* convs) {
    const int gt = (c.vcu * NWAVES + c.wave) * 64 + c.lane, NT = c.G * NWAVES * 64;
    for (int idx = gt; idx < 8 * FF; idx += NT) {
        const int b = idx / FF, j = idx - b * FF, pn = j >> 7, jj = j & 127;
        const float ug = US[(size_t)b * FF2 + 256 * pn + jj], uv = US[(size_t)b * FF2 + 256 * pn + 128 + jj];
        { float* uz = const_cast<float*>(US); uz[(size_t)b * FF2 + 256 * pn + jj] = 0.f; uz[(size_t)b * FF2 + 256 * pn + 128 + jj] = 0.f; }
        const float* s0 = st + (size_t)b * 2 * FF2; const float* s1 = s0 + FF2;
        const float cg = cb[j] + cw[j] * s0[j] + cw[FF2 + j] * s1[j] + cw[2 * FF2 + j] * ug;
        const float cv = cb[FF + j] + cw[FF + j] * s0[FF + j] + cw[FF2 + FF + j] * s1[FF + j] + cw[2 * FF2 + FF + j] * uv;
        ACTS[(size_t)b * FF + j] = (bf16)(pk2(cg * sigmoidf_(cg) * cv, 0.f) & 0xffffu);
        float* o = convs + (size_t)b * 2 * FF2; o[j] = s1[j]; o[FF + j] = s1[FF + j]; o[FF2 + j] = ug; o[FF2 + FF + j] = uv;
    }
}


__device__ __forceinline__ void conv_fixup(const Ctx& c, const float* part, const float* halou, bf16* ACT, const float* cw) {
    const int gt = (c.vcu * NWAVES + c.wave) * 64 + c.lane, NT = c.G * NWAVES * 64;
    for (int idx = gt; idx < 32 * 2 * FF; idx += NT) {
        const int pm = idx / (2 * FF), rem = idx - pm * 2 * FF, r = rem / FF, j = rem - r * FF, pn = j >> 7, jj = j & 127;
        if ((pm & 7) == 0) continue;
        const size_t ci = 256 * pn + jj;
        float cg = part[((size_t)pm * 2 + r) * FF2 + ci], cv = part[((size_t)pm * 2 + r) * FF2 + ci + 128];
        const float ug2 = halou[((size_t)(pm - 1) * 2 + 0) * FF2 + ci], ug1 = halou[((size_t)(pm - 1) * 2 + 1) * FF2 + ci];
        const float uv2 = halou[((size_t)(pm - 1) * 2 + 0) * FF2 + ci + 128], uv1 = halou[((size_t)(pm - 1) * 2 + 1) * FF2 + ci + 128];
        if (r == 0) { cg += cw[j] * ug2 + cw[FF2 + j] * ug1; cv += cw[FF + j] * uv2 + cw[FF2 + FF + j] * uv1; }
        else { cg += cw[j] * ug1; cv += cw[FF + j] * uv1; }
        ACT[((size_t)pm * 256 + r) * FF + j] = (bf16)(pk2(cg * sigmoidf_(cg) * cv, 0.f) & 0xffffu);
    }
}

__device__ __forceinline__ void ssm_prompt(const Ctx& c, const bf16* US, bf16* Z, const float* lam_re, const float* lam_im, const float* log_dt, const float* b_re, const float* b_im,
                                           const float* c_re, const float* c_im, const float* d_skip, float* ssm_out) {
    const int lane = c.lane, cq = lane & 15, rq = lane >> 4, sq = c.wave >> 2, q = c.wave & 3;
    LAS unsigned* BU = (LAS unsigned*)(c.lds + c.wave * 12544);
    LAS unsigned char* XL = c.lds + c.wave * 12544 + 8192;
    LAS f32x2* EX = (LAS f32x2*)(c.lds + 8 * 12544);
    for (int it0 = c.vcu; it0 < 256; it0 += c.G) {
        const int it = sq * 256 + it0, b = it >> 7, g = it & 127;
        const float lr = fminf(lam_re[g * 64 + lane], -1e-4f), lim = lam_im[g * 64 + lane], dt = __expf(log_dt[g]);
        const float mag = __expf(lr * dt); float sn, cs_; sincos_rr(lim * dt, sn, cs_);
        const float ar = mag * cs_, ai = mag * sn;
        const float den = 1.0f / (lr * lr + lim * lim), nr = ar - 1.0f;
        const float cr = (nr * lr + ai * lim) * den, ci = (ai * lr - nr * lim) * den;
        bf16x4 bb[8];
#pragma unroll
        for (int jn = 0; jn < 8; ++jn) { const int pp = 16 * (jn & 3) + cq; const float crr = __shfl(cr, pp), cii = __shfl(ci, pp);
            const f32x4 br = *(const f32x4*)(b_re + (size_t)(g * 64 + pp) * 16 + 4 * rq), bi = *(const f32x4*)(b_im + (size_t)(g * 64 + pp) * 16 + 4 * rq);
            float v[4];
#pragma unroll
            for (int e = 0; e < 4; ++e) v[e] = (jn >= 4) ? (crr * bi[e] + cii * br[e]) : (crr * br[e] - cii * bi[e]);
            u32x2 wv; wv.x = pk2(v[0], v[1]); wv.y = pk2(v[2], v[3]); bb[jn] = __builtin_bit_cast(bf16x4, wv); }
        const size_t rowbase = (size_t)b * 2048 + 512 * q;
        float xr = 0.f, xi = 0.f;
        const bf16* up0 = US + (rowbase + cq) * 2048 + 16 * g + 4 * rq;
        bf16x4 ua = *(const bf16x4*)up0, ub = *(const bf16x4*)(up0 + (size_t)16 * 2048);
        for (int ch = 0; ch < 32; ++ch) {
            const bf16x4 ua_n = *(const bf16x4*)(up0 + (size_t)(ch < 30 ? ch + 2 : 31) * 16 * 2048);
#pragma unroll
            for (int jn = 0; jn < 4; ++jn) { f32x4 dr = __builtin_amdgcn_mfma_f32_16x16x16bf16_1k(ua, bb[jn], (f32x4){0.f, 0.f, 0.f, 0.f}, 0, 0, 0), di = __builtin_amdgcn_mfma_f32_16x16x16bf16_1k(ua, bb[jn + 4], (f32x4){0.f, 0.f, 0.f, 0.f}, 0, 0, 0);
#pragma unroll
                for (int e = 0; e < 4; ++e) BU[(4 * rq + e) * 64 + 16 * jn + cq] = pk2v(dr[e], di[e]); }
            LDS_WAIT();
#pragma unroll
            for (int tt = 0; tt < 16; ++tt) { const unsigned bw = BU[tt * 64 + lane]; const f32x2 bu = (f32x2){bflo(bw), bfhi(bw)};
                const float nxr = __builtin_fmaf(ar, xr, __builtin_fmaf(-ai, xi, bu.x)), nxi = __builtin_fmaf(ar, xi, __builtin_fmaf(ai, xr, bu.y)); xr = nxr; xi = nxi; }
            LDS_WAIT();
            ua = ub; ub = ua_n;
        }
        EX[(sq * 4 + q) * 64 + lane] = (f32x2){xr, xi};
        __syncthreads();
        float pr = ar, pi = ai;
#pragma unroll
        for (int k = 0; k < 9; ++k) { const float t = pr * pr - pi * pi; pi = 2.0f * pr * pi; pr = t; }
        xr = 0.f; xi = 0.f;
        for (int qq = 0; qq < q; ++qq) { const f32x2 e = EX[(sq * 4 + qq) * 64 + lane]; const float nxr = pr * xr - pi * xi + e.x, nxi = pr * xi + pi * xr + e.y; xr = nxr; xi = nxi; }
        bf16x8 cf[4];
#pragma unroll
        for (int ks = 0; ks < 4; ++ks) { const f32x4 cre = *(const f32x4*)(c_re + (size_t)(g * 16 + cq) * 64 + 16 * ks + 4 * rq), cim = *(const f32x4*)(c_im + (size_t)(g * 16 + cq) * 64 + 16 * ks + 4 * rq);
            u32x4 wv; wv.x = pk2(cre[0], -cim[0]); wv.y = pk2(cre[1], -cim[1]); wv.z = pk2(cre[2], -cim[2]); wv.w = pk2(cre[3], -cim[3]); cf[ks] = __builtin_bit_cast(bf16x8, wv); }
        const f32x4 dsk = *(const f32x4*)(d_skip + 16 * g + 4 * rq);
        ua = *(const bf16x4*)up0; ub = *(const bf16x4*)(up0 + (size_t)16 * 2048);
        for (int ch = 0; ch < 32; ++ch) {
            const size_t off = (rowbase + 16 * ch + cq) * 2048 + 16 * g + 4 * rq;
            const bf16x4 ua_n = *(const bf16x4*)(up0 + (size_t)(ch < 30 ? ch + 2 : 31) * 16 * 2048);
#pragma unroll
            for (int jn = 0; jn < 4; ++jn) { f32x4 dr = __builtin_amdgcn_mfma_f32_16x16x16bf16_1k(ua, bb[jn], (f32x4){0.f, 0.f, 0.f, 0.f}, 0, 0, 0), di = __builtin_amdgcn_mfma_f32_16x16x16bf16_1k(ua, bb[jn + 4], (f32x4){0.f, 0.f, 0.f, 0.f}, 0, 0, 0);
#pragma unroll
                for (int e = 0; e < 4; ++e) BU[(4 * rq + e) * 64 + 16 * jn + cq] = pk2v(dr[e], di[e]); }
            LDS_WAIT();
#pragma unroll
            for (int tt = 0; tt < 16; ++tt) { const unsigned bw = BU[tt * 64 + lane]; const f32x2 bu = (f32x2){bflo(bw), bfhi(bw)};
                const float nxr = __builtin_fmaf(ar, xr, __builtin_fmaf(-ai, xi, bu.x)), nxi = __builtin_fmaf(ar, xi, __builtin_fmaf(ai, xr, bu.y)); xr = nxr; xi = nxi;
                *(LAS unsigned*)(XL + tt * 272 + 4 * lane) = pk2(xr, xi); }
            LDS_WAIT();
            f32x4 a = (f32x4){0.f, 0.f, 0.f, 0.f};
#pragma unroll
            for (int ks = 0; ks < 4; ++ks) a = __builtin_amdgcn_mfma_f32_16x16x32_bf16(cf[ks], *(const LAS bf16x8*)(XL + cq * 272 + 64 * ks + 16 * rq), a, 0, 0, 0);
            const u32x2 uw = __builtin_bit_cast(u32x2, ua);
            const float y0 = a[0] + dsk[0] * bflo(uw.x), y1 = a[1] + dsk[1] * bfhi(uw.x), y2 = a[2] + dsk[2] * bflo(uw.y), y3 = a[3] + dsk[3] * bfhi(uw.y);
            u32x2 zw; zw.x = pk2(gelu_tanh(y0), gelu_tanh(y1)); zw.y = pk2(gelu_tanh(y2), gelu_tanh(y3));
            *(u32x2*)(Z + off) = zw;
            LDS_WAIT();
            ua = ub; ub = ua_n;
        }
        if (q == 3) *(f32x2*)(ssm_out + ((size_t)(b * 128 + g) * 64 + lane) * 2) = (f32x2){xr, xi};
        __syncthreads();
    }
}
__device__ __forceinline__ void ssm_sample(const Ctx& c, const float* USS, const float* h0, bf16* ZS, const float* lam_re, const float* lam_im, const float* log_dt, const float* b_re, const float* b_im,
                                           const float* c_re, const float* c_im, const float* d_skip, float* ssm_out) {
    const int gw = c.vcu * NWAVES + c.wave, NGW = c.G * NWAVES, lane = c.lane;
    for (int it = gw; it < 1024; it += NGW) {
        const int b = it >> 7, g = it & 127;
        const float lr = fminf(lam_re[g * 64 + lane], -1e-4f), lim = lam_im[g * 64 + lane], dt = __expf(log_dt[g]);
        const float mag = __expf(lr * dt); float sn, cs_; sincos_rr(lim * dt, sn, cs_);
        const float ar = mag * cs_, ai = mag * sn;
        const float den = 1.0f / (lr * lr + lim * lim), nr = ar - 1.0f;
        const float cr = (nr * lr + ai * lim) * den, ci = (ai * lr - nr * lim) * den;
        float u[16]; float sr = 0.f, si = 0.f;
#pragma unroll
        for (int k = 0; k < 16; ++k) { u[k] = USS[(size_t)b * 2048 + 16 * g + k]; sr += b_re[(size_t)(g * 64 + lane) * 16 + k] * u[k]; si += b_im[(size_t)(g * 64 + lane) * 16 + k] * u[k]; }
        const f32x2 hv = *(const f32x2*)(h0 + ((size_t)(b * 128 + g) * 64 + lane) * 2);
        const float xr = ar * hv.x - ai * hv.y + (cr * sr - ci * si), xi = ar * hv.y + ai * hv.x + (cr * si + ci * sr);
        *(f32x2*)(ssm_out + ((size_t)(b * 128 + g) * 64 + lane) * 2) = (f32x2){xr, xi};
        float myz = 0.f;
#pragma unroll
        for (int k = 0; k < 16; ++k) { const float y = wave_sum(c_re[(size_t)(g * 16 + k) * 64 + lane] * xr - c_im[(size_t)(g * 16 + k) * 64 + lane] * xi) + d_skip[16 * g + k] * u[k];
            const float z = gelu_tanh(y); myz = (lane == k) ? z : myz; }
        if (lane < 16) { ZS[(size_t)b * 2048 + 16 * g + lane] = (bf16)(pk2(myz, 0.f) & 0xffffu); const_cast<float*>(USS)[(size_t)b * 2048 + 16 * g + lane] = 0.f; }
    }
}


#define DIS_ATTN(...) __VA_ARGS__
#define DIS_ATTNS(...) __VA_ARGS__
#define DIS_SSM(...) __VA_ARGS__
#define DIS_SSMS(...) __VA_ARGS__
#define DIS_CONV(...) __VA_ARGS__
#define DIS_G1(...) __VA_ARGS__
#define DIS_G2(...) __VA_ARGS__
#define DIS_G3(...) __VA_ARGS__
#define DIS_G4(...) __VA_ARGS__


#define ATTN_FN attn_prompt
#define SSM_FN ssm_prompt

#ifndef ABL_ATTN_P
#define ABL_ATTN_P 1.0f
#endif
#ifndef ABL_ATTN_S
#define ABL_ATTN_S 1.0f
#endif
#ifndef ABL_SSM_P
#define ABL_SSM_P 1.0f
#endif
#ifndef ABL_SSM_S
#define ABL_SSM_S 1.0f
#endif
#ifndef ABL_FFN_P
#define ABL_FFN_P 1.0f
#endif
#ifndef ABL_FFN_S
#define ABL_FFN_S 1.0f
#endif
#ifndef ABL_S_A0
#define ABL_S_A0 1.0f
#endif
#ifndef ABL_S_A1
#define ABL_S_A1 1.0f
#endif
#ifndef ABL_S_S0
#define ABL_S_S0 1.0f
#endif
#ifndef ABL_S_S1
#define ABL_S_S1 1.0f
#endif
#ifndef ABL_S_F0
#define ABL_S_F0 1.0f
#endif
#ifndef ABL_S_F1
#define ABL_S_F1 1.0f
#endif
#ifndef ABL_S_F2
#define ABL_S_F2 1.0f
#endif
#ifndef ABL_S_F3
#define ABL_S_F3 1.0f
#endif
#define GEMM_FN gemm_phase
#ifndef ABL_P_A0
#define ABL_P_A0 1.0f
#endif
#ifndef ABL_P_A1
#define ABL_P_A1 1.0f
#endif
#ifndef ABL_P_S0
#define ABL_P_S0 1.0f
#endif
#ifndef ABL_P_S1
#define ABL_P_S1 1.0f
#endif
#ifndef ABL_P_F0
#define ABL_P_F0 1.0f
#endif
#ifndef ABL_P_F1
#define ABL_P_F1 1.0f
#endif
#ifndef ABL_P_F2
#define ABL_P_F2 1.0f
#endif
#ifndef ABL_P_F3
#define ABL_P_F3 1.0f
#endif
#define QKV_GEMM_CALL DIS_G1(pg8::GEMM_FN<pg8::EpiQKV, pg8::StaticOrder, true, true>(c.lds, g, S, E));
#define QKV_POST(LI)
#define GLU_EPI pg8::EpiGLU E{WSP(bf16, WS_M)}; DIS_G4(pg8::GEMM_FN<pg8::EpiGLU, pg8::StaticOrder, true, true>(c.lds, g, S, E));
#define GLU_POSTNORM(LI) postnorm_rows<false, false, true>(c, MP, args.out + O_YP, args.out + O_YP, WSP(const float, WS_M), D, NG(2 * (LI) + 1, 1), NG(2 * (LI) + 1, 2), WSP(bf16, WS_H), ((LI) == 0 ? ABL_P_S0 : ABL_P_S1));
#define UPGEMM_CALL pg8::GEMM_FN<pg8::EpiConv, pg8::StaticOrder, true, true>(c.lds, g, S, E);
struct Args { const float* in[24]; float* out; unsigned char* ws; int ph_lo, ph_hi; };
enum { I_XP = 0, I_XS, I_CK0, I_CK1, I_CK2, I_SSSM, I_SCONV, I_NG, I_WQKV, I_WO, I_WIN, I_LRE, I_LIM, I_LDT, I_BRE, I_BIM, I_CRE, I_CIM, I_DSK, I_WGLU, I_WUP, I_CW, I_CB, I_WDN };
#define WSP(T, off) ((T*)(args.ws + (off)))
#define SMP(T, off) ((T*)(args.ws + WS_SMP + (off)))
#define NG(i, j) (args.in[I_NG] + (size_t)((i) * 4 + (j)) * D)

#define PH_ATTN_LAYER(LI, PB) \
    if (IN((PB) + 0)) {     \
        const bf16* Wqkv = WSP(const bf16, WS_WQKV + (LI) * WQKV_L); \
        { pg8::Gemm g{WSP(const bf16, WS_H), Wqkv, MP, NQKV, D}; pg8::StaticOrder S; S.init(MP, NQKV, c.G, (int)blockIdx.x); \
          pg8::EpiQKV E{WSP(bf16, WS_Q), WSP(bf16, WS_VT), WSP(const float, WS_CS), args.out, (LI), 0.08838834764831845f * 1.4426950408889634f}; \
          QKV_GEMM_CALL } \
        skinny_gemm(c, SMP(const bf16, SM_HS), Wqkv, NQKV, D, SMP(float, SM_QKV), 128); \
        CONVQ_TAIL((PB) + 0, 128, CQ_CAPQ); \
    } \
    SEAM((PB) + 0); \
    QKV_POST((LI)) \
    if (IN((PB) + 1)) {     \
        DIS_ATTN(ATTN_FN(c, WSP(const bf16, WS_Q), WSP(const bf16, WS_K), WSP(const bf16, WS_VT), WSP(bf16, WS_OG), WSP(float, WS_LSE), WSP(float, WS_LL))); \
        DIS_ATTNS(attn_sample<0>(c, (LI), SMP(const float, SM_QKV), WSP(const float, WS_CS), args.in[I_CK0], SMP(float, SM_OSG), SMP(float, SM_LSE), args.out + O_KV0S)); \
        DIS_ATTNS(attn_sample<1>(c, (LI), SMP(const float, SM_QKV), WSP(const float, WS_CS), args.in[I_CK1], SMP(float, SM_OSG), SMP(float, SM_LSE), args.out + O_KV1S)); \
        DIS_ATTNS(attn_sample<2>(c, (LI), SMP(const float, SM_QKV), WSP(const float, WS_CS), args.in[I_CK2], SMP(float, SM_OSG), SMP(float, SM_LSE), args.out + O_KV2S)); \
    } \
    SEAM((PB) + 1); \
    if (IN((PB) + 2)) { merge_prompt(c, WSP(const bf16, WS_OG), WSP(const float, WS_LSE), WSP(const float, WS_LL), WSP(bf16, WS_O)); merge_sample(c, SMP(const float, SM_OSG), SMP(const float, SM_LSE), SMP(bf16, SM_OS)); } \
    SEAM((PB) + 2); \
    if (IN((PB) + 3)) {     \
        const bf16* Wo = WSP(const bf16, WS_WO + (LI) * WO_L); \
        { pg8::Gemm g{WSP(const bf16, WS_O), Wo, MP, D, AW}; pg8::StaticOrder S; S.init(MP, D, c.G, (int)blockIdx.x); \
          pg8::EpiBf16 E{WSP(bf16, WS_M), D}; \
          pg8::GEMM_FN<pg8::EpiBf16, pg8::StaticOrder, true, true>(c.lds, g, S, E); } \
        skinny_gemm(c, SMP(const bf16, SM_OS), Wo, D, AW, SMP(float, SM_MS)); \
    } \
    SEAM((PB) + 3); \
    if (IN((PB) + 4)) { \
        postnorm_rows<false, false, true>(c, MP, (LI) == 0 ? args.in[I_XP] : args.out + O_YP, args.out + O_YP, WSP(const float, WS_M), D, NG(2 * (LI), 1), NG(2 * (LI), 2), WSP(bf16, WS_H), ((LI) == 0 ? ABL_P_A0 : ABL_P_A1)); \
        postnorm_rows<false, true>(c, NS, (LI) == 0 ? args.in[I_XS] : args.out + O_YS, args.out + O_YS, SMP(const float, SM_MS), D, NG(2 * (LI), 1), NG(2 * (LI), 2), SMP(bf16, SM_HS), ((LI) == 0 ? ABL_S_A0 : ABL_S_A1)); \
    } \
    SEAM((PB) + 4);

#define PH_SSM_LAYER(LI, PB) \
    if (IN((PB) + 0)) {     \
        const bf16* Win = WSP(const bf16, WS_WIN + (LI) * WIN_L); \
        { pg8::Gemm g{WSP(const bf16, WS_H), Win, MP, D, D}; pg8::StaticOrder S; S.init(MP, D, c.G, (int)blockIdx.x); \
          pg8::EpiBf16 E{WSP(bf16, WS_USSM), D}; \
          DIS_G3(pg8::GEMM_FN<pg8::EpiBf16, pg8::StaticOrder, true, true>(c.lds, g, S, E)); } \
        skinny_gemm(c, SMP(const bf16, SM_HS), Win, D, D, SMP(float, SM_USSM)); \
    } \
    SEAM((PB) + 0); \
    if (IN((PB) + 1)) { \
        const size_t o1 = (size_t)(LI) * 128 * 64, o2 = (size_t)(LI) * 128, o3 = (size_t)(LI) * 128 * 64 * 16, o4 = (size_t)(LI) * 2048; \
        DIS_SSM(SSM_FN(c, WSP(const bf16, WS_USSM), WSP(bf16, WS_Z), args.in[I_LRE] + o1, args.in[I_LIM] + o1, args.in[I_LDT] + o2, args.in[I_BRE] + o3, args.in[I_BIM] + o3, args.in[I_CRE] + o3, args.in[I_CIM] + o3, args.in[I_DSK] + o4, args.out + O_SSMP + (LI) * SSMP_L)); \
        DIS_SSMS(ssm_sample(c, SMP(const float, SM_USSM), args.in[I_SSSM] + (size_t)(LI) * SSMS_L, SMP(bf16, SM_ZS), args.in[I_LRE] + o1, args.in[I_LIM] + o1, args.in[I_LDT] + o2, args.in[I_BRE] + o3, args.in[I_BIM] + o3, args.in[I_CRE] + o3, args.in[I_CIM] + o3, args.in[I_DSK] + o4, args.out + O_SSMS + (LI) * SSMS_L)); \
    } \
    SEAM((PB) + 1); \
    if (IN((PB) + 2)) {     \
        const bf16* Wglu = WSP(const bf16, WS_WGLU + (LI) * WGLU_L); \
        { pg8::Gemm g{WSP(const bf16, WS_Z), Wglu, MP, GLU2, D}; pg8::StaticOrder S; S.init(MP, GLU2, c.G, (int)blockIdx.x); \
          GLU_EPI } \
        skinny_gemm(c, SMP(const bf16, SM_ZS), Wglu, GLU2, D, SMP(float, SM_MS)); \
    } \
    SEAM((PB) + 2); \
    if (IN((PB) + 3)) { \
        GLU_POSTNORM((LI)) \
        postnorm_rows<true, true>(c, NS, args.out + O_YS, args.out + O_YS, SMP(const float, SM_MS), GLU2, NG(2 * (LI) + 1, 1), NG(2 * (LI) + 1, 2), SMP(bf16, SM_HS), ((LI) == 0 ? ABL_S_S0 : ABL_S_S1)); \
    } \
    SEAM((PB) + 3);

#define PH_FFN(I, FB) \
    if (IN((FB) + 0)) {     \
        const bf16* Wup = WSP(const bf16, WS_WUP + (I) * WUP_L); \
        { pg8::Gemm g{WSP(const bf16, WS_H), Wup, MP, FF2, D}; pg8::StaticOrder S; S.init(MP, FF2, c.G, (int)blockIdx.x); \
          pg8::EpiConv E{WSP(bf16, WS_ACT), args.in[I_CW] + (size_t)(I) * 3 * FF2, args.in[I_CB] + (size_t)(I) * FF2, WSP(float, WS_U), WSP(float, WS_U) + 64 * FF2, args.out + O_CONVP + (I) * CONVP_L, (PG8_LAS float*)(c.lds + 132096)}; \
          UPGEMM_CALL } \
        skinny_gemm(c, SMP(const bf16, SM_HS), Wup, FF2, D, SMP(float, SM_US), 96); \
        CONVQ_TAIL((FB) + 0, 96, CQ_CAPU); \
    } \
    SEAM((FB) + 0); \
    if (IN((FB) + 1)) { \
        conv_fixup(c, WSP(const float, WS_U), WSP(const float, WS_U) + 64 * FF2, WSP(bf16, WS_ACT), args.in[I_CW] + (size_t)(I) * 3 * FF2); \
        conv_sample(c, SMP(const float, SM_US), args.in[I_SCONV] + (size_t)(I) * CONVS_L, SMP(bf16, SM_ACT), args.in[I_CW] + (size_t)(I) * 3 * FF2, args.in[I_CB] + (size_t)(I) * FF2, args.out + O_CONVS + (I) * CONVS_L); \
    } \
    SEAM((FB) + 1); \
    if (IN((FB) + 2)) {     \
        const bf16* Wdn = WSP(const bf16, WS_WDN + (I) * WDN_L); \
        { pg8::Gemm g{WSP(const bf16, WS_ACT), Wdn, MP, D, FF}; pg8::StaticOrder S; S.init(MP, D, c.G, (int)blockIdx.x); \
          pg8::EpiBf16 E{WSP(bf16, WS_M), D}; \
          pg8::GEMM_FN<pg8::EpiBf16, pg8::StaticOrder, true, true>(c.lds, g, S, E); } \
        skinny_gemm(c, SMP(const bf16, SM_ACT), Wdn, D, FF, SMP(float, SM_MS)); \
    } \
    SEAM((FB) + 2); \
    if (IN((FB) + 3)) { \
        const float* g2 = ((I) < 3) ? NG((I) + 1, 0) : nullptr; \
        postnorm_rows<false, false, true>(c, MP, args.out + O_YP, args.out + O_YP, WSP(const float, WS_M), D, NG((I), 3), g2, WSP(bf16, WS_H), ((I) == 0 ? ABL_P_F0 : (I) == 1 ? ABL_P_F1 : (I) == 2 ? ABL_P_F2 : ABL_P_F3)); \
        postnorm_rows<false, true>(c, NS, args.out + O_YS, args.out + O_YS, SMP(const float, SM_MS), D, NG((I), 3), g2, SMP(bf16, SM_HS), ((I) == 0 ? ABL_S_F0 : (I) == 1 ? ABL_S_F1 : (I) == 2 ? ABL_S_F2 : ABL_S_F3)); \
    } \
    SEAM((FB) + 3);

__global__ void __launch_bounds__(NWAVES * 64, 2) fwd_kernel(Args args) {
    extern __shared__ __attribute__((aligned(16))) unsigned char lds_raw[];
    Ctx c; c.lds = (LAS unsigned char*)lds_raw; c.tid = threadIdx.x; c.lane = c.tid & 63; c.wave = __builtin_amdgcn_readfirstlane(c.tid >> 6);
    c.G = gridDim.x; { const int bx = blockIdx.x; c.vcu = (c.G % 8 == 0) ? (bx % 8) * (c.G / 8) + bx / 8 : bx; }
    volatile LAS unsigned* MISC = (volatile LAS unsigned*)(c.lds + MISC_OFF);
    if (c.tid < 32) MISC[c.tid] = 0u;
    __syncthreads();
    XcdBarrier bar = xcd_barrier_post((unsigned*)(args.ws + WS_CTL) + CW_BAR, MISC + 8);
    const int lo = args.ph_lo, hi = args.ph_hi;
#define IN(k) (lo <= (k) && (k) < hi)
#define DBG_STAMP(i) do { } while (0)
#define SEAM(k) do { CONVQ_SEAM(k); if (IN(k) && IN((k) + 1)) xcd_barrier(bar); DBG_STAMP((k) + 1); } while (0)
    DBG_STAMP(0);

    if (IN(0)) {
        CONVQ_RANGE(0, convq_need(1), c.vcu * NWAVES + c.wave, c.G * NWAVES, 0);
        build_cs(c, WSP(float, WS_CS));
        zero_f32(c, SMP(float, SM_QKV), 8 * NQKV); zero_f32(c, SMP(float, SM_MS), 8 * GLU2); zero_f32(c, SMP(float, SM_US), 8 * FF2); zero_f32(c, SMP(float, SM_USSM), 8 * D);
        prenorm_rows(c, MP, args.in[I_XP], args.in[I_NG], WSP(bf16, WS_H));
        prenorm_rows(c, NS, args.in[I_XS], args.in[I_NG], SMP(bf16, SM_HS));
    }
    SEAM(0);
    PH_ATTN_LAYER(0, 1)
    PH_FFN(0, 6)
    PH_SSM_LAYER(0, 10)
    PH_FFN(1, 14)
    PH_ATTN_LAYER(1, 18)
    PH_FFN(2, 23)
    PH_SSM_LAYER(1, 27)
    PH_FFN(3, 31)
#undef IN
#undef SEAM
}

#ifndef MK_PER_PHASE
#define MK_PER_PHASE 0
#endif
extern "C" void kernel_launch(void* const* d_in, const int* in_sizes, int n_in, void* d_out, int out_size, void* d_ws, size_t ws_size, hipStream_t stream) {
    static int grid = 0;
    if (grid == 0) {
        if (n_in != 24 || in_sizes[0] != MP * D || (size_t)out_size != O_END || ws_size < WS_END) {
            fprintf(stderr, "kernel_launch: shape mismatch: n_in %d in0 %d out %d ws %zu (need 24, %d, %zu, >= %zu); nothing launched\n", n_in, n_in > 0 ? in_sizes[0] : -1, out_size, ws_size, MP * D, (size_t)O_END, (size_t)WS_END); grid = -1; return; }
        { const long long exp_sz[24] = {(long long)MP * D, (long long)NS * D, 2LL * 8 * 128 * 2048, 2LL * 8 * 512 * 2048, 2LL * 8 * 2048 * 2048, 2LL * 8 * 128 * 64 * 2, 4LL * 8 * 2 * FF2, 4LL * 4 * D,
              2LL * D * NQKV, 2LL * AW * D, 2LL * D * D, 2LL * 128 * 64, 2LL * 128 * 64, 2LL * 128, 2LL * 128 * 64 * 16, 2LL * 128 * 64 * 16, 2LL * 128 * 16 * 64, 2LL * 128 * 16 * 64, 2LL * D, 2LL * D * GLU2,
              4LL * D * FF2, 4LL * 3 * FF2, 4LL * FF2, 4LL * FF * D};
          for (int i = 0; i < 24; ++i) if ((long long)in_sizes[i] != exp_sz[i]) { fprintf(stderr, "kernel_launch: input %d has %d elements, expected %lld; nothing launched\n", i, in_sizes[i], exp_sz[i]); grid = -1; return; } }
        int dev = 0, cus = 0, per_cu = 0;
        if (hipGetDevice(&dev) != hipSuccess || hipDeviceGetAttribute(&cus, hipDeviceAttributeMultiprocessorCount, dev) != hipSuccess) { fprintf(stderr, "kernel_launch: device query failed\n"); grid = -1; return; }
        if (hipFuncSetAttribute((const void*)fwd_kernel, hipFuncAttributeMaxDynamicSharedMemorySize, LDS_BYTES) != hipSuccess) { fprintf(stderr, "kernel_launch: hipFuncSetAttribute failed\n"); grid = -1; return; }
        if (hipOccupancyMaxActiveBlocksPerMultiprocessor(&per_cu, (const void*)fwd_kernel, NWAVES * 64, LDS_BYTES) != hipSuccess || per_cu < 1)
            fprintf(stderr, "kernel_launch: note: occupancy query reports %d workgroups per CU\n", per_cu);
        (void)hipGetLastError();
        grid = cus;
        if (grid != 256) { fprintf(stderr, "kernel_launch: %d CUs (built for 256); nothing launched\n", grid); grid = -1; return; }
    }
    if (grid < 0) return;
    if (hipMemsetAsync((char*)d_ws + WS_CTL, 0, CTL_ZERO_BYTES, stream) != hipSuccess) { fprintf(stderr, "kernel_launch: memset failed\n"); return; }
    Args a{};
    for (int i = 0; i < 24; ++i) a.in[i] = (const float*)d_in[i];
    a.out = (float*)d_out; a.ws = (unsigned char*)d_ws;
#if MK_PER_PHASE
    for (int p = 0; p < N_PHASES; ++p) { a.ph_lo = p; a.ph_hi = p + 1; hipLaunchKernelGGL(fwd_kernel, dim3(grid), dim3(NWAVES * 64), LDS_BYTES, stream, a); }
#else
    a.ph_lo = 0; a.ph_hi = N_PHASES;
    hipLaunchKernelGGL(fwd_kernel, dim3(grid), dim3(NWAVES * 64), LDS_BYTES, stream, a);
#endif
    const hipError_t le = hipPeekAtLastError();
    if (le != hipSuccess) fprintf(stderr, "kernel_launch: launch failed: %s\n", hipGetErrorName(le));
}
```

```cpp
#include <hip/hip_runtime.h>
#include <cstdio>
#include <cstdint>

constexpr int NWAVES = 8;
constexpr int NB = 4, T = 2048, D = 2048, MP = NB * T, NS = 8;
constexpr int NQKV = 9216, AW = 1024, FF = 5504, FF2 = 11008, GLU2 = 4096;
constexpr float RMS_EPS = 1e-6f;
constexpr int N_PHASES = 35;

constexpr size_t O_YP = 0;
constexpr size_t O_YS = O_YP + (size_t)MP * D;
constexpr size_t KV0P_L = (size_t)4 * 128 * 2048, KV1P_L = (size_t)4 * 512 * 2048, KV2P_L = (size_t)4 * 2048 * 2048, KVS_L = 8 * 2048;
constexpr size_t O_KV0P = O_YS + (size_t)NS * D;
constexpr size_t O_KV0S = O_KV0P + 2 * KV0P_L;
constexpr size_t O_KV1P = O_KV0S + 2 * KVS_L;
constexpr size_t O_KV1S = O_KV1P + 2 * KV1P_L;
constexpr size_t O_KV2P = O_KV1S + 2 * KVS_L;
constexpr size_t O_KV2S = O_KV2P + 2 * KV2P_L;
constexpr size_t O_SSMP = O_KV2S + 2 * KVS_L;
constexpr size_t SSMP_L = 4 * 128 * 64 * 2, SSMS_L = 8 * 128 * 64 * 2;
constexpr size_t O_SSMS = O_SSMP + 2 * SSMP_L;
constexpr size_t O_CONVP = O_SSMS + 2 * SSMS_L;
constexpr size_t CONVP_L = 4 * 2 * FF2, CONVS_L = 8 * 2 * FF2;
constexpr size_t O_CONVS = O_CONVP + 4 * CONVP_L;
constexpr size_t O_END = O_CONVS + 4 * CONVS_L;
static_assert(O_END == 62382080, "d_out layout");

namespace pg8 {
#define PG8_LAS __attribute__((address_space(3)))
typedef unsigned short bf16_t;
typedef short bf16x8 __attribute__((ext_vector_type(8)));
typedef float f32x4 __attribute__((ext_vector_type(4)));
typedef unsigned u32x4 __attribute__((ext_vector_type(4)));
constexpr int BM = 256, BK = 64, HALF = 128, HTB = HALF * BK * 2  , STAGE_BYTES = 8 * HTB, NXCD = 8, WGM = 8;

__host__ __device__ __forceinline__ int lds_byte(int r, int c) { const int st = (r >> 4) * 2 + (c >> 5), rr = r & 15, cc = c & 31, ob = rr * 64 + cc * 2; return st * 1024 + (ob ^ (((ob >> 9) & 1) << 5)); }
__host__ __device__ __forceinline__ void stage_rc(int b, int& R, int& C) { const int st = b / 1024, sb = b % 1024, swz = sb ^ (((sb >> 9) & 1) << 5); R = (st >> 1) * 16 + swz / 64; C = (st & 1) * 32 + (swz % 64) / 2; }
__host__ __device__ __forceinline__ int perm32(int rho) { const int n = rho >> 4, i = rho & 15; return 8 * (i >> 2) + 4 * n + (i & 3); }

struct Unit { int pm, pn; };
struct Gemm { const bf16_t* A; const bf16_t* Bt; int M, N, K; };

struct StaticOrder {
    int nM, nN, nwg, G, c;
    __host__ __device__ void init(int M, int N, int G_, int c_) { nM = M / BM; nN = N / BM; nwg = nM * nN; G = G_; c = c_; }
    __host__ __device__ bool next(int i, Unit& u) const {
        const long L = (long)i * G + c; if (L >= nwg) return false;
        int wgid = (int)L; { const int q = nwg / NXCD, r = nwg % NXCD, xcd = wgid % NXCD, off = wgid / NXCD; wgid = (xcd < r ? xcd * (q + 1) : r * (q + 1) + (xcd - r) * q) + off; }
        const int nig = WGM * nN, gid = wgid / nig, fm = gid * WGM, gsz = (nM - fm) < WGM ? (nM - fm) : WGM;
        u.pm = fm + ((wgid % nig) % gsz); u.pn = (wgid % nig) / gsz; return true;
    }
    __device__ __forceinline__ void a_ready(const Unit&) const {}
    __device__ __forceinline__ void done(const Unit&) const {}
};


__device__ __forceinline__ unsigned cvt_pk_bf16(float lo, float hi) { unsigned r; asm volatile("v_cvt_pk_bf16_f32 %0, %1, %2" : "=v"(r) : "v"(lo), "v"(hi)); return r; }
typedef unsigned u32x2 __attribute__((ext_vector_type(2)));

struct EpiF32 {
    static constexpr bool PERM = false, AFTER_DRAIN = false;
    float* C; int ldc;
    __device__ __forceinline__ void operator()(const f32x4 (&acc)[2][2][4][2], const Unit& u, int wr, int wc, int fr, int fq) const {
        const int row0 = u.pm * BM + wr * 64 + fr, col0 = u.pn * BM + wc * 32 + 4 * fq;
#pragma unroll
        for (int ai = 0; ai < 2; ++ai)
#pragma unroll
            for (int m = 0; m < 4; ++m) { float* rowp = C + (size_t)(row0 + ai * HALF + m * 16) * ldc + col0;
#pragma unroll
                for (int bj = 0; bj < 2; ++bj)
#pragma unroll
                    for (int n = 0; n < 2; ++n) *(f32x4*)(rowp + bj * HALF + n * 16) = acc[ai][bj][m][n]; }
    }
};
struct EpiBf16 {
    static constexpr bool PERM = true, AFTER_DRAIN = false;
    bf16_t* O; int ldc;
    __device__ __forceinline__ void operator()(const f32x4 (&acc)[2][2][4][2], const Unit& u, int wr, int wc, int fr, int fq) const {
        const int row0 = u.pm * BM + wr * 64 + fr, col0 = u.pn * BM + wc * 32 + 8 * fq;
#pragma unroll
        for (int ai = 0; ai < 2; ++ai)
#pragma unroll
            for (int m = 0; m < 4; ++m) { bf16_t* rowp = O + (size_t)(row0 + ai * HALF + m * 16) * ldc + col0;
#pragma unroll
                for (int bj = 0; bj < 2; ++bj) { const f32x4 v0 = acc[ai][bj][m][0], v1 = acc[ai][bj][m][1];
                    u32x4 w; w.x = cvt_pk_bf16(v0[0], v0[1]); w.y = cvt_pk_bf16(v0[2], v0[3]); w.z = cvt_pk_bf16(v1[0], v1[1]); w.w = cvt_pk_bf16(v1[2], v1[3]);
                    *(u32x4*)(rowp + bj * HALF) = w; } }
    }
};
struct EpiGLU {
    static constexpr bool PERM = true, AFTER_DRAIN = false;
    bf16_t* C;
    __device__ __forceinline__ void operator()(const f32x4 (&acc)[2][2][4][2], const Unit& u, int wr, int wc, int fr, int fq) const {
        const int row0 = u.pm * BM + wr * 64 + fr, col0 = u.pn * HALF + wc * 32 + 8 * fq;
#pragma unroll
        for (int ai = 0; ai < 2; ++ai)
#pragma unroll
            for (int m = 0; m < 4; ++m) { bf16_t* rowp = C + (size_t)(row0 + ai * HALF + m * 16) * 2048 + col0; u32x4 w;
#pragma unroll
                for (int n = 0; n < 2; ++n) { const f32x4 a = acc[ai][0][m][n], g = acc[ai][1][m][n]; f32x4 o;
#pragma unroll
                    for (int e = 0; e < 4; ++e) o[e] = a[e] * __builtin_amdgcn_rcpf(1.0f + __builtin_amdgcn_exp2f(-1.44269504089f * g[e]));
                    if (n == 0) { w.x = cvt_pk_bf16(o[0], o[1]); w.y = cvt_pk_bf16(o[2], o[3]); } else { w.z = cvt_pk_bf16(o[0], o[1]); w.w = cvt_pk_bf16(o[2], o[3]); } }
                *(u32x4*)rowp = w; }
    }
};
struct EpiQKV {
    static constexpr bool PERM = true, AFTER_DRAIN = false;
    bf16_t* Q; bf16_t* VT; const float* cs; float* out; int li; float qscale;
    __device__ __forceinline__ void operator()(const f32x4 (&acc)[2][2][4][2], const Unit& u, int wr, int wc, int fr, int fq) const {
        const int which = u.pn / 12, rem = u.pn - which * 12, g = rem >> 2, hp = rem & 3;
        const int dsh = 2 * g, S = 2048 >> dsh, keep = 128 << dsh;
        const size_t kvoff = g == 0 ? (O_KV0P + (size_t)li * KV0P_L) : (g == 1 ? (O_KV1P + (size_t)li * KV1P_L) : (O_KV2P + (size_t)li * KV2P_L));
        float* kvout = out + kvoff;
        const int d0 = wc * 32 + 8 * fq;
        const bool rot = (which < 2) && (wc == 0);
        const bool hi = fq >= 2;
#pragma unroll
        for (int ai = 0; ai < 2; ++ai)
#pragma unroll
            for (int m = 0; m < 4; ++m) {
                const int row = u.pm * BM + ai * HALF + wr * 64 + m * 16 + fr;
                const int b = row >> 11, t = row & 2047;
                const int idx = (t & ((1 << dsh) - 1)) * S + (t >> dsh);
                f32x4 c0 = (f32x4){1.f, 1.f, 1.f, 1.f}, c1 = c0, s0 = (f32x4){0.f, 0.f, 0.f, 0.f}, s1 = s0;
                if (rot) { const float* cp = cs + t * 32 + 8 * (fq & 1); c0 = *(const f32x4*)cp; c1 = *(const f32x4*)(cp + 4); s0 = *(const f32x4*)(cp + 16); s1 = *(const f32x4*)(cp + 20); }
#pragma unroll
                for (int bj = 0; bj < 2; ++bj) {
                    const int h = 2 * hp + bj, bgh = (b * 3 + g) * 8 + h;
                    f32x4 v0 = acc[ai][bj][m][0], v1 = acc[ai][bj][m][1];
                    if (rot) {
                        f32x4 p0, p1;
#pragma unroll
                        for (int e = 0; e < 4; ++e) { p0[e] = __shfl_xor(v0[e], 32); p1[e] = __shfl_xor(v1[e], 32); }
                        if (hi) { v0 = v0 * c0 + p0 * s0; v1 = v1 * c1 + p1 * s1; } else { v0 = v0 * c0 - p0 * s0; v1 = v1 * c1 - p1 * s1; }
                    }
                    if (which >= 1) { const int tt = t - (2048 - keep);
                        if (tt >= 0) { float* o = kvout + ((((size_t)b * keep + tt) * 2 + (which - 1)) * 8 + h) * 128 + d0; *(f32x4*)o = v0; *(f32x4*)(o + 4) = v1; } }
                    if (which == 0) { v0 = v0 * qscale; v1 = v1 * qscale; }
                    bf16_t* o = Q + (size_t)which * ((size_t)48 << 19) + ((size_t)bgh * 2048 + idx) * 128 + d0;
                    u32x4 w; w.x = cvt_pk_bf16(v0[0], v0[1]); w.y = cvt_pk_bf16(v0[2], v0[3]); w.z = cvt_pk_bf16(v1[0], v1[1]); w.w = cvt_pk_bf16(v1[2], v1[3]);
                    *(u32x4*)o = w;
                }
            }
    }
};
__device__ __forceinline__ float dpp_shr1(float cur, float prevgrp) {
    const int x = __builtin_amdgcn_update_dpp(0, __float_as_int(prevgrp), 0x121, 0xF, 0xF, false);
    return __int_as_float(__builtin_amdgcn_update_dpp(x, __float_as_int(cur), 0x111, 0xF, 0xF, false)); }
__device__ __forceinline__ float dpp_shr2(float cur, float prevgrp) {
    const int x = __builtin_amdgcn_update_dpp(0, __float_as_int(prevgrp), 0x122, 0xF, 0xF, false);
    return __int_as_float(__builtin_amdgcn_update_dpp(x, __float_as_int(cur), 0x112, 0xF, 0xF, false)); }
struct EpiConv {
    static constexpr bool PERM = true, AFTER_DRAIN = false;
    bf16_t* ACT; const float* cw; const float* cb; float* part; float* halou; float* convp; PG8_LAS float* halo;
    __device__ __forceinline__ void operator()(const f32x4 (&acc)[2][2][4][2], const Unit& u, int wr, int wc, int fr, int fq) const {
        constexpr int FFc = 5504, FF2c = 11008;
        if (fr >= 14) {
#pragma unroll
            for (int ai = 0; ai < 2; ++ai)
#pragma unroll
                for (int bj = 0; bj < 2; ++bj)
#pragma unroll
                    for (int n = 0; n < 2; ++n) *(PG8_LAS f32x4*)(halo + ((((ai * 2 + wr) * 4 + wc) * 2 + (fr - 14)) * 64 + bj * 32 + 8 * fq + 4 * n)) = acc[ai][bj][3][n];
            if (wr == 1) {
#pragma unroll
                for (int bj = 0; bj < 2; ++bj)
#pragma unroll
                    for (int n = 0; n < 2; ++n) { const int cs_ = bj * HALF + wc * 32 + 8 * fq + 4 * n;
                        *(f32x4*)(halou + ((size_t)u.pm * 2 + (fr - 14)) * FF2c + u.pn * BM + cs_) = acc[1][bj][3][n];
                        if ((u.pm & 7) == 7) *(f32x4*)(convp + ((size_t)(u.pm >> 3) * 2 + (fr - 14)) * FF2c + bj * FFc + u.pn * HALF + wc * 32 + 8 * fq + 4 * n) = acc[1][bj][3][n]; }
            }
        }
        asm volatile("s_waitcnt lgkmcnt(0)" ::: "memory"); __builtin_amdgcn_s_barrier(); asm volatile("" ::: "memory");
        const bool seq_start = (u.pm & 7) == 0;
        u32x2 keep[2][4];
#pragma unroll
        for (int n = 0; n < 2; ++n) {
            const int jg = u.pn * HALF + wc * 32 + 8 * fq + 4 * n;
            const f32x4 bg = *(const f32x4*)(cb + jg), bv = *(const f32x4*)(cb + FFc + jg);
            const f32x4 g0w = *(const f32x4*)(cw + jg), g1w = *(const f32x4*)(cw + FF2c + jg), g2w = *(const f32x4*)(cw + 2 * FF2c + jg);
            const f32x4 v0w = *(const f32x4*)(cw + FFc + jg), v1w = *(const f32x4*)(cw + FF2c + FFc + jg), v2w = *(const f32x4*)(cw + 2 * FF2c + FFc + jg);
#pragma unroll
            for (int ai = 0; ai < 2; ++ai)
#pragma unroll
                for (int m = 0; m < 4; ++m) {
                    const f32x4 cg = acc[ai][0][m][n], cv = acc[ai][1][m][n];
                    f32x4 pg = (f32x4){0.f, 0.f, 0.f, 0.f}, pv = (f32x4){0.f, 0.f, 0.f, 0.f};
                    if (m > 0) { pg = acc[ai][0][m - 1][n]; pv = acc[ai][1][m - 1][n]; }
                    else if (!(ai == 0 && wr == 0)) { const int pai = wr == 1 ? ai : ai - 1, pwr = wr == 1 ? 0 : 1;
                        if (fr >= 14) { const PG8_LAS float* hp = halo + ((((pai * 2 + pwr) * 4 + wc) * 2 + (fr - 14)) * 64 + 8 * fq + 4 * n); pg = *(const PG8_LAS f32x4*)hp; pv = *(const PG8_LAS f32x4*)(hp + 32); } }
                    f32x4 og, ov;
#pragma unroll
                    for (int e = 0; e < 4; ++e) {
                        const float g1 = dpp_shr1(cg[e], pg[e]), g2 = dpp_shr2(cg[e], pg[e]), v1 = dpp_shr1(cv[e], pv[e]), v2 = dpp_shr2(cv[e], pv[e]);
                        og[e] = bg[e] + g0w[e] * g2 + g1w[e] * g1 + g2w[e] * cg[e]; ov[e] = bv[e] + v0w[e] * v2 + v1w[e] * v1 + v2w[e] * cv[e]; }
                    const int row = u.pm * BM + ai * HALF + wr * 64 + m * 16 + fr;
                    const bool partial = (ai == 0 && wr == 0 && m == 0 && fr < 2 && !seq_start);
                    if (partial) { float* pp = part + ((size_t)u.pm * 2 + fr) * FF2c + u.pn * BM + wc * 32 + 8 * fq + 4 * n; *(f32x4*)pp = og; *(f32x4*)(pp + HALF) = ov; }
                    f32x4 a;
#pragma unroll
                    for (int e = 0; e < 4; ++e) a[e] = og[e] * __builtin_amdgcn_rcpf(1.0f + __builtin_amdgcn_exp2f(-1.44269504089f * og[e])) * ov[e];
                    u32x2 w; w.x = cvt_pk_bf16(a[0], a[1]); w.y = cvt_pk_bf16(a[2], a[3]);
                    if (n == 0) keep[ai][m] = w;
                    else if (!partial) { u32x4 w4; w4.x = keep[ai][m].x; w4.y = keep[ai][m].y; w4.z = w.x; w4.w = w.y; *(u32x4*)(ACT + (size_t)row * FFc + jg - 4) = w4; }
                }
        }
    }
};

template <class Epi, class Sched, bool ALIGN_EPI = false, bool SP2 = false>
__device__ __forceinline__ void gemm_phase(PG8_LAS unsigned char* lds, const Gemm g, const Sched& S, const Epi& E) {
    const int tid = threadIdx.x, wid = __builtin_amdgcn_readfirstlane(tid >> 6), lane = tid & 63, wr = wid >> 2, wc = wid & 3, fr = lane & 15, fq = lane >> 4;
    const int K = g.K, nt = K / BK;
    unsigned voffA[2], voffB[2];
#pragma unroll
    for (int i = 0; i < 2; ++i) { int R, C; stage_rc(tid * 16 + i * 8192, R, C); const int Rb = Epi::PERM ? ((R & ~31) + perm32(R & 31)) : R;
        voffA[i] = (unsigned)(R * K + C) * 2u; voffB[i] = (unsigned)(Rb * K + C) * 2u; }
    const size_t kstep = (size_t)(BK * 2);
    const size_t hstep = (size_t)HALF * K * 2;
    const size_t tstep = 2 * hstep;
    const unsigned ldsw = (unsigned)wid * 1024u;
    const int aoff = lds_byte(wr * 64 + fr, fq * 8), boff = lds_byte(wc * 32 + fr, fq * 8);
#define PG8_SA(b, h) (((b) * 2 + (h)) * HTB)
#define PG8_SB(b, h) ((4 + (b) * 2 + (h)) * HTB)
#define PG8_STAGE(bufoff, gbase, voff) do { _Pragma("unroll") for (int _i = 0; _i < 2; ++_i) \
        __builtin_amdgcn_global_load_lds((const unsigned*)((const char*)(gbase) + (voff)[_i]), (PG8_LAS unsigned*)(lds + (bufoff) + ldsw + _i * 8192), 16, 0, 0); } while (0)
#define PG8_LDA(dst, b, h) do { _Pragma("unroll") for (int m = 0; m < 4; ++m) _Pragma("unroll") for (int k = 0; k < 2; ++k) dst[m][k] = *(const PG8_LAS bf16x8*)(lds + PG8_SA(b, h) + aoff + m * 2048 + k * 1024); } while (0)
#define PG8_LDB(dst, b, h) do { _Pragma("unroll") for (int n = 0; n < 2; ++n) _Pragma("unroll") for (int k = 0; k < 2; ++k) dst[n][k] = *(const PG8_LAS bf16x8*)(lds + PG8_SB(b, h) + boff + n * 2048 + k * 1024); } while (0)
#define PG8_MMA(ai, bj, At, Bt) do { __builtin_amdgcn_s_setprio(1); _Pragma("unroll") for (int m = 0; m < 4; ++m) _Pragma("unroll") for (int n = 0; n < 2; ++n) _Pragma("unroll") for (int k = 0; k < 2; ++k) \
        acc[ai][bj][m][n] = __builtin_amdgcn_mfma_f32_16x16x32_bf16(Bt[n][k], At[m][k], acc[ai][bj][m][n], 0, 0, 0); __builtin_amdgcn_s_setprio(0); } while (0)
#define PG8_WAIT_V(n) asm volatile("s_waitcnt vmcnt(" #n ")" ::: "memory")
#define PG8_WAIT_L(n) asm volatile("s_waitcnt lgkmcnt(" #n ")" ::: "memory")
#define PG8_BAR __builtin_amdgcn_s_barrier()
#define PG8_SCHED __builtin_amdgcn_sched_barrier(0)
    Unit cur, nxt; int ui = 0;
    if (!S.next(0, cur)) return;
    f32x4 acc[2][2][4][2];
#pragma unroll
    for (int a = 0; a < 2; ++a)
#pragma unroll
        for (int b = 0; b < 2; ++b)
#pragma unroll
            for (int m = 0; m < 4; ++m)
#pragma unroll
                for (int n = 0; n < 2; ++n) acc[a][b][m][n] = (f32x4){0.f, 0.f, 0.f, 0.f};
    bf16x8 At[4][2], B0[2][2], B1[2][2];
    const char* cA = (const char*)g.A + (size_t)cur.pm * tstep; const char* cB = (const char*)g.Bt + (size_t)cur.pn * tstep;
    S.a_ready(cur);
    if constexpr (SP2) {
        PG8_STAGE(PG8_SB(0, 0), cB, voffB); PG8_STAGE(PG8_SB(0, 1), cB + hstep, voffB); PG8_STAGE(PG8_SA(0, 0), cA, voffA); PG8_STAGE(PG8_SA(0, 1), cA + hstep, voffA);
        if (wr == 1) PG8_BAR;
        PG8_WAIT_V(2); PG8_BAR;
        PG8_STAGE(PG8_SB(1, 0), cB + kstep, voffB); PG8_STAGE(PG8_SA(1, 0), cA + kstep, voffA); PG8_STAGE(PG8_SB(1, 1), cB + hstep + kstep, voffB);
        PG8_WAIT_V(6); PG8_BAR;
    } else {
        PG8_STAGE(PG8_SB(0, 0), cB, voffB); PG8_STAGE(PG8_SA(0, 0), cA, voffA); PG8_STAGE(PG8_SB(0, 1), cB + hstep, voffB); PG8_STAGE(PG8_SA(0, 1), cA + hstep, voffA);
        if (wr == 1) PG8_BAR;
        PG8_WAIT_V(4); PG8_BAR;
        PG8_STAGE(PG8_SB(1, 0), cB + kstep, voffB); PG8_STAGE(PG8_SA(1, 0), cA + kstep, voffA); PG8_STAGE(PG8_SB(1, 1), cB + hstep + kstep, voffB);
        PG8_WAIT_V(6); PG8_BAR;
    }
    for (;;) {
        const bool has_next = S.next(ui + 1, nxt);
        const char* nA = has_next ? (const char*)g.A + (size_t)nxt.pm * tstep : cA; const char* nB = has_next ? (const char*)g.Bt + (size_t)nxt.pn * tstep : cB;
        for (int t = 0; t < nt; t += 2) {
            const bool last = (t == nt - 2);
            const char* a1 = cA + (size_t)(t + 1) * kstep;
            const char* a2 = last ? nA : cA + (size_t)(t + 2) * kstep; const char* b2 = last ? nB : cB + (size_t)(t + 2) * kstep;
            const char* a3 = a2 + kstep; const char* b3 = b2 + kstep;
            if (last && has_next) S.a_ready(nxt);
            if constexpr (SP2) {
            PG8_LDB(B0, 0, 0); PG8_LDB(B1, 0, 1); PG8_SCHED; PG8_LDA(At, 0, 0); PG8_STAGE(PG8_SA(1, 1), a1 + hstep, voffA);
            PG8_WAIT_V(8); PG8_WAIT_L(0); PG8_BAR; PG8_MMA(0, 0, At, B0); PG8_MMA(0, 1, At, B1); PG8_BAR; PG8_SCHED;
            PG8_LDA(At, 0, 1); PG8_STAGE(PG8_SB(0, 0), b2, voffB); PG8_STAGE(PG8_SB(0, 1), b2 + hstep, voffB); PG8_STAGE(PG8_SA(0, 0), a2, voffA);
            PG8_WAIT_V(8); PG8_WAIT_L(0); PG8_BAR; PG8_MMA(1, 0, At, B0); PG8_MMA(1, 1, At, B1); PG8_BAR; PG8_SCHED;
            PG8_LDB(B0, 1, 0); PG8_LDB(B1, 1, 1); PG8_SCHED; PG8_LDA(At, 1, 0); PG8_STAGE(PG8_SA(0, 1), a2 + hstep, voffA);
            PG8_WAIT_V(8); PG8_WAIT_L(0); PG8_BAR; PG8_MMA(0, 0, At, B0); PG8_MMA(0, 1, At, B1); PG8_BAR; PG8_SCHED;
            PG8_LDA(At, 1, 1); PG8_STAGE(PG8_SB(1, 0), b3, voffB); PG8_STAGE(PG8_SB(1, 1), b3 + hstep, voffB); PG8_STAGE(PG8_SA(1, 0), a3, voffA);
            PG8_WAIT_V(8); PG8_WAIT_L(0); PG8_BAR; PG8_MMA(1, 0, At, B0); PG8_MMA(1, 1, At, B1); PG8_BAR; PG8_SCHED;
            } else {
            PG8_LDB(B0, 0, 0); PG8_SCHED; PG8_LDA(At, 0, 0); PG8_STAGE(PG8_SA(1, 1), a1 + hstep, voffA);
            PG8_WAIT_L(8); PG8_BAR; PG8_WAIT_L(0); PG8_MMA(0, 0, At, B0); PG8_BAR; PG8_SCHED;
            PG8_LDB(B1, 0, 1); PG8_STAGE(PG8_SB(0, 0), b2, voffB);
            PG8_BAR; PG8_WAIT_L(0); PG8_MMA(0, 1, At, B1); PG8_BAR;
            PG8_LDA(At, 0, 1); PG8_STAGE(PG8_SA(0, 0), a2, voffA);
            PG8_BAR; PG8_WAIT_L(0); PG8_MMA(1, 0, At, B0); PG8_BAR; PG8_SCHED;
            PG8_STAGE(PG8_SB(0, 1), b2 + hstep, voffB);
            PG8_WAIT_V(6); PG8_BAR; PG8_MMA(1, 1, At, B1); PG8_BAR;
            PG8_LDB(B0, 1, 0); PG8_SCHED; PG8_LDA(At, 1, 0); PG8_STAGE(PG8_SA(0, 1), a2 + hstep, voffA);
            PG8_WAIT_L(8); PG8_BAR; PG8_WAIT_L(0); PG8_MMA(0, 0, At, B0); PG8_BAR; PG8_SCHED;
            PG8_LDB(B1, 1, 1); PG8_STAGE(PG8_SB(1, 0), b3, voffB);
            PG8_BAR; PG8_WAIT_L(0); PG8_MMA(0, 1, At, B1); PG8_BAR;
            PG8_LDA(At, 1, 1); PG8_STAGE(PG8_SA(1, 0), a3, voffA);
            PG8_BAR; PG8_WAIT_L(0); PG8_MMA(1, 0, At, B0); PG8_BAR; PG8_SCHED;
            PG8_STAGE(PG8_SB(1, 1), b3 + hstep, voffB);
            PG8_WAIT_V(6); PG8_BAR; PG8_MMA(1, 1, At, B1); PG8_BAR;
            }
        }
        if constexpr (ALIGN_EPI) { if (wr == 0) PG8_BAR; }
        if constexpr (!Epi::AFTER_DRAIN) { E(acc, cur, wr, wc, fr, fq); S.done(cur); }
        if (!has_next) break;
#pragma unroll
        for (int a = 0; a < 2; ++a)
#pragma unroll
            for (int b = 0; b < 2; ++b)
#pragma unroll
                for (int m = 0; m < 4; ++m)
#pragma unroll
                    for (int n = 0; n < 2; ++n) acc[a][b][m][n] = (f32x4){0.f, 0.f, 0.f, 0.f};
        cur = nxt; cA = nA; cB = nB; ++ui;
        if constexpr (ALIGN_EPI) { if (wr == 1) PG8_BAR; }
    }
    PG8_WAIT_V(0);
    if constexpr (!ALIGN_EPI) { if (wr == 0) PG8_BAR; }
    PG8_BAR;
    if constexpr (Epi::AFTER_DRAIN) { E.fused(acc, cur, wr, wc, fr, fq, lds, wid, lane); S.done(cur); }
#undef PG8_SA
#undef PG8_SB
#undef PG8_STAGE
#undef PG8_LDA
#undef PG8_LDB
#undef PG8_MMA
#undef PG8_WAIT_V
#undef PG8_WAIT_L
#undef PG8_BAR
#undef PG8_SCHED
}

}

constexpr size_t MiB = 1u << 20;
constexpr size_t WS_CTL = 0, CTL_ZERO_BYTES = 1 * MiB;
constexpr size_t WS_CS = 1 * MiB;
constexpr size_t WS_SMP = 2 * MiB;
constexpr size_t WS_WQKV = 4 * MiB,  WQKV_L = (size_t)NQKV * D * 2;
constexpr size_t WS_WO = 76 * MiB,   WO_L = (size_t)D * AW * 2;
constexpr size_t WS_WIN = 84 * MiB,  WIN_L = (size_t)D * D * 2;
constexpr size_t WS_WGLU = 100 * MiB, WGLU_L = (size_t)GLU2 * D * 2;
constexpr size_t WS_WUP = 132 * MiB, WUP_L = (size_t)FF2 * D * 2;
constexpr size_t WS_WDN = 304 * MiB, WDN_L = (size_t)D * FF * 2;
constexpr size_t WS_H = 390 * MiB;
constexpr size_t WS_Q = 422 * MiB, WS_K = 470 * MiB, WS_VT = 518 * MiB;
constexpr size_t WS_OG = 566 * MiB;
constexpr size_t WS_LSE = 614 * MiB;
constexpr size_t WS_O = 615 * MiB;
constexpr size_t WS_M = 631 * MiB;
constexpr size_t WS_U = 695 * MiB;
constexpr size_t WS_ACT = 867 * MiB;
constexpr size_t WS_USSM = 953 * MiB;
constexpr size_t WS_Z = 985 * MiB;
constexpr size_t WS_LL = 1017 * MiB;
constexpr size_t WS_END = 1018 * MiB;
static_assert(WS_WQKV + 2 * WQKV_L <= WS_WO && WS_WO + 2 * WO_L <= WS_WIN && WS_WIN + 2 * WIN_L <= WS_WGLU && WS_WGLU + 2 * WGLU_L <= WS_WUP && WS_WUP + 4 * WUP_L <= WS_WDN && WS_WDN + 4 * WDN_L <= WS_H, "ws map (weights)");
static_assert(WS_U + (size_t)MP * FF2 * 2 <= WS_ACT && WS_ACT + (size_t)MP * FF * 2 <= WS_USSM, "ws map (acts)");
constexpr size_t SM_HS = 0;
constexpr size_t SM_QKV = 64 * 1024;
constexpr size_t SM_OSG = 384 * 1024;
constexpr size_t SM_LSE = 512 * 1024;
constexpr size_t SM_OS = 528 * 1024;
constexpr size_t SM_MS = 576 * 1024;
constexpr size_t SM_US = 704 * 1024;
constexpr size_t SM_ACT = 1088 * 1024;
constexpr size_t SM_ZS = 1216 * 1024;
constexpr size_t SM_USSM = 1280 * 1024;
constexpr int CW_BAR = 4096;
constexpr int CW_CONVQ = 12288;

constexpr int RING_BYTES = 131072;
constexpr int LDS_BYTES = 163840;
constexpr int MISC_OFF = LDS_BYTES - 256;

#ifndef CONV_TAILS
#define CONV_TAILS 1
#endif
#ifndef CONV_NQ
#define CONV_NQ 8
#endif
#ifndef CONV_NU
#define CONV_NU 7
#endif
#ifndef CONV_KT
#define CONV_KT 64
#endif
#define LAS __attribute__((address_space(3)))
typedef unsigned short bf16;
typedef float f32x4 __attribute__((ext_vector_type(4)));
typedef float f32x2 __attribute__((ext_vector_type(2)));
typedef short bf16x8 __attribute__((ext_vector_type(8)));
typedef short bf16x4 __attribute__((ext_vector_type(4)));
typedef unsigned u32x4 __attribute__((ext_vector_type(4)));
typedef unsigned u32x2 __attribute__((ext_vector_type(2)));
#define LDS_WAIT() asm volatile("s_waitcnt lgkmcnt(0)" ::: "memory")
__device__ __forceinline__ unsigned pk2(float lo, float hi) { return pg8::cvt_pk_bf16(lo, hi); }
typedef __bf16 bf16v2 __attribute__((ext_vector_type(2)));
__device__ __forceinline__ unsigned pk2v(float lo, float hi) { return __builtin_bit_cast(unsigned, __builtin_convertvector((f32x2){lo, hi}, bf16v2)); }
__device__ __forceinline__ float bf2f(unsigned short b) { return __uint_as_float(((unsigned)b) << 16); }
__device__ __forceinline__ float bflo(unsigned w) { return __uint_as_float(w << 16); }
__device__ __forceinline__ float bfhi(unsigned w) { return __uint_as_float(w & 0xffff0000u); }
__device__ __forceinline__ float wave_sum(float v) {
#pragma unroll
    for (int o = 1; o < 64; o <<= 1) v += __shfl_xor(v, o);
    return v;
}
__device__ __forceinline__ float sigmoidf_(float x) { return __builtin_amdgcn_rcpf(1.0f + __builtin_amdgcn_exp2f(-1.44269504089f * x)); }
__device__ __forceinline__ float gelu_tanh(float y) { const float z = 0.7978845608028654f * (y + 0.044715f * y * y * y); return y * sigmoidf_(2.0f * z); }
__device__ __forceinline__ void sincos_rr(float ang, float& s, float& c) {
    const double x = (double)ang, kd = rint(x * 0.63661977236758134308), r = fma(-kd, 1.57079632679489661923, x) - kd * 6.123233995736766e-17, r2 = r * r;
    double sp = 1.0 / 6227020800.0; sp = sp * r2 - 1.0 / 39916800.0; sp = sp * r2 + 1.0 / 362880.0; sp = sp * r2 - 1.0 / 5040.0; sp = sp * r2 + 1.0 / 120.0; sp = sp * r2 - 1.0 / 6.0; sp = sp * r2 * r + r;
    double cp = -1.0 / 87178291200.0; cp = cp * r2 + 1.0 / 479001600.0; cp = cp * r2 - 1.0 / 3628800.0; cp = cp * r2 + 1.0 / 40320.0; cp = cp * r2 - 1.0 / 720.0; cp = cp * r2 + 1.0 / 24.0; cp = cp * r2 - 0.5; cp = cp * r2 + 1.0;
    const int q = (int)((long long)kd & 3);
    const double ss = (q & 1) ? cp : sp, cc = (q & 1) ? sp : cp;
    s = (float)((q & 2) ? -ss : ss); c = (float)(((q + 1) & 2) ? -cc : cc);
}
#define XB_TMO      128
#define XB_XCNT(j)  (256  + 64 * (j))
#define XB_XSUB(j)  (1280 + 64 * (j))
#define XB_XGEN(j)  (2304 + 64 * (j))
#define XB_TOP      3328
#define XB_TOPGEN   3392
#define XCD_BAR_WORDS 3456
#define XB_SPIN_CAP (1u << 18)

__device__ __forceinline__ unsigned xb_ld(unsigned* p)              { return __hip_atomic_load(p, __ATOMIC_RELAXED, __HIP_MEMORY_SCOPE_AGENT); }
__device__ __forceinline__ unsigned xb_add(unsigned* p, unsigned v) { return __hip_atomic_fetch_add(p, v, __ATOMIC_RELAXED, __HIP_MEMORY_SCOPE_AGENT); }
__device__ __forceinline__ unsigned xb_xcc_id() { return (unsigned)__builtin_amdgcn_s_getreg((3 << 11) | 20) & 0xFu; }
#define XB_SPIN(cond, bar) do { unsigned _sp = 0; while (cond) { __builtin_amdgcn_s_sleep(1); \
    if ((++_sp & 255u) == 0u) { if (xb_ld(&(bar)[XB_TMO])) break; if (_sp > XB_SPIN_CAP) { atomicAdd(&(bar)[XB_TMO], 1u); break; } } } } while (0)

struct XcdBarrier {
    unsigned* bar; unsigned x;
    volatile LAS unsigned* st;
};

__device__ __forceinline__ XcdBarrier xcd_barrier_post(unsigned* bar, volatile LAS unsigned* st) {
    XcdBarrier b; b.bar = bar; b.x = xb_xcc_id(); b.st = st;
    if (threadIdx.x == 0) (void)xb_add(&bar[XB_XCNT(b.x)], 1u);
    return b;
}
__device__ __forceinline__ void xcd_barrier_complete(unsigned* bar, unsigned x, unsigned& nloc, unsigned& nx) {
    const unsigned G = gridDim.x * gridDim.y * gridDim.z;
    unsigned sum, cnt, mine, sp = 0u;
    for (;;) {
        sum = 0u; cnt = 0u; mine = 0u;
#pragma unroll
        for (unsigned j = 0; j < 16; ++j) { const unsigned c = xb_ld(&bar[XB_XCNT(j)]); sum += c; cnt += (c > 0u) ? 1u : 0u; mine = (j == x) ? c : mine; }
        if (sum == G) break;
        __builtin_amdgcn_s_sleep(1);
        if ((++sp & 255u) == 0u) { if (xb_ld(&bar[XB_TMO])) break; if (sp > XB_SPIN_CAP) { atomicAdd(&bar[XB_TMO], 1u); break; } }
    }
    nloc = mine > 0u ? mine : 1u; nx = cnt > 0u ? cnt : 1u;
}

__device__ __forceinline__ void xcd_barrier(const XcdBarrier& b) {
    asm volatile("s_waitcnt vmcnt(0)" ::: "memory");
    __syncthreads();
    if (threadIdx.x == 0) {
        unsigned* bar = b.bar;
        __builtin_amdgcn_s_waitcnt(0);
        unsigned nloc = b.st[0], nx = b.st[1];
        if (nloc == 0u) { xcd_barrier_complete(bar, b.x, nloc, nx); b.st[0] = nloc; b.st[1] = nx; }
        const unsigned old = xb_add(&bar[XB_XSUB(b.x)], 1u);
        const unsigned gen = old / nloc;
        if (old + 1u == (gen + 1u) * nloc) {
            __builtin_amdgcn_fence(__ATOMIC_RELEASE, "agent");
            asm volatile("s_waitcnt vmcnt(0)" ::: "memory");
            const unsigned og = xb_add(&bar[XB_TOP], 1u);
            const unsigned tg = og / nx;
            if (og + 1u == (tg + 1u) * nx) xb_add(&bar[XB_TOPGEN], 1u);
            else XB_SPIN(xb_ld(&bar[XB_TOPGEN]) == tg, bar);
            __builtin_amdgcn_fence(__ATOMIC_ACQUIRE, "agent");
            xb_add(&bar[XB_XGEN(b.x)], 1u);
            asm volatile("s_waitcnt vmcnt(0)" ::: "memory");
        } else {
            XB_SPIN(xb_ld(&bar[XB_XGEN(b.x)]) == gen, bar);
            __builtin_amdgcn_fence(__ATOMIC_ACQUIRE, "agent");
            asm volatile("s_waitcnt vmcnt(0)" ::: "memory");
        }
    }
    __syncthreads();
}

struct Ctx { LAS unsigned char* lds; int tid, lane, wave, vcu, G; };

__device__ __forceinline__ void convert_item(const float* W, int K, int N, int IL, bf16* WT, int it, LAS float* scr, int lane) {
    const int nblk = N / 32, kb = it / nblk, nb = it - kb * nblk, n0 = 32 * nb, k0 = 64 * kb;
    int drow0 = n0;
    if (IL > 0) { const int isv = n0 >= IL ? 1 : 0, j = n0 - isv * IL; drow0 = (j >> 7) * 256 + isv * 128 + (j & 127); }
    const float* src = W + (size_t)(k0 + (lane >> 5)) * N + n0 + (lane & 31);
    float v[32];
#pragma unroll
    for (int i = 0; i < 32; ++i) v[i] = src[(size_t)(2 * i) * N];
#pragma unroll
    for (int i = 0; i < 32; ++i) scr[(2 * i + (lane >> 5)) * 33 + (lane & 31)] = v[i];
    LDS_WAIT(); asm volatile("" ::: "memory");
    const int cc = lane & 7;
#pragma unroll
    for (int j = 0; j < 4; ++j) { const int n = (lane >> 3) + 8 * j; const LAS float* s = scr + (8 * cc) * 33 + n;
        u32x4 o; o.x = pk2(s[0 * 33], s[1 * 33]); o.y = pk2(s[2 * 33], s[3 * 33]); o.z = pk2(s[4 * 33], s[5 * 33]); o.w = pk2(s[6 * 33], s[7 * 33]);
        *(u32x4*)(WT + (size_t)(drow0 + n) * K + k0 + 8 * cc) = o; }
    LDS_WAIT(); asm volatile("" ::: "memory");
}
constexpr int CQ_QKV = 9216, CQ_O = 1024, CQ_UP = 11008, CQ_DN = 5504, CQ_IN = 2048, CQ_GLU = 4096;
constexpr int CQ_L = CQ_QKV + CQ_O + CQ_UP + CQ_DN + CQ_IN + CQ_GLU + CQ_UP + CQ_DN;
constexpr int CQ_TOTAL = 2 * CQ_L;
__host__ __device__ constexpr int convq_need(int p) {
    if (p <= 0) return 0; if (p >= N_PHASES) return CQ_TOTAL;
    const int li = (p - 1) / 17, q = (p - 1) % 17;
    int n = li * CQ_L + CQ_QKV; if (q >= 1) n += 0;
    if (q >= 3) n += CQ_O; if (q >= 5) n += CQ_UP; if (q >= 7) n += CQ_DN; if (q >= 9) n += CQ_IN; if (q >= 11) n += CQ_GLU; if (q >= 13) n += CQ_UP; if (q >= 15) n += CQ_DN;
    if (q == 16 && li == 0) n += 0;
    return n;
}
__device__ __forceinline__ void convq_process(LAS unsigned char* lds, int wave, int lane, int it, const float* wqkv, const float* wo, const float* win, const float* wglu, const float* wup, const float* wdn, unsigned char* ws) {
    LAS float* scr = (LAS float*)(lds + wave * 17408);
    const int li = it >= CQ_L ? 1 : 0; int r = it - li * CQ_L;
    const float* W; bf16* WT; int K, N, IL = 0;
    if (r < CQ_QKV) { W = wqkv + (size_t)li * D * NQKV; K = D; N = NQKV; WT = (bf16*)(ws + WS_WQKV + li * WQKV_L); }
    else if ((r -= CQ_QKV) < CQ_O) { W = wo + (size_t)li * AW * D; K = AW; N = D; WT = (bf16*)(ws + WS_WO + li * WO_L); }
    else if ((r -= CQ_O) < CQ_UP) { W = wup + (size_t)(2 * li) * D * FF2; K = D; N = FF2; IL = FF; WT = (bf16*)(ws + WS_WUP + (2 * li) * WUP_L); }
    else if ((r -= CQ_UP) < CQ_DN) { W = wdn + (size_t)(2 * li) * FF * D; K = FF; N = D; WT = (bf16*)(ws + WS_WDN + (2 * li) * WDN_L); }
    else if ((r -= CQ_DN) < CQ_IN) { W = win + (size_t)li * D * D; K = D; N = D; WT = (bf16*)(ws + WS_WIN + li * WIN_L); }
    else if ((r -= CQ_IN) < CQ_GLU) { W = wglu + (size_t)li * D * GLU2; K = D; N = GLU2; IL = 2048; WT = (bf16*)(ws + WS_WGLU + li * WGLU_L); }
    else if ((r -= CQ_GLU) < CQ_UP) { W = wup + (size_t)(2 * li + 1) * D * FF2; K = D; N = FF2; IL = FF; WT = (bf16*)(ws + WS_WUP + (2 * li + 1) * WUP_L); }
    else { r -= CQ_UP; W = wdn + (size_t)(2 * li + 1) * FF * D; K = FF; N = D; WT = (bf16*)(ws + WS_WDN + (2 * li + 1) * WDN_L); }
    convert_item(W, K, N, IL, WT, r, scr, lane);
}
constexpr int CQ_CAPQ = 128 * 8 * CONV_NQ, CQ_CAPU = 160 * 8 * CONV_NU;
__host__ __device__ constexpr bool cq_is_q(int p) { return p >= 1 && ((p - 1) % 17) == 0; }
__host__ __device__ constexpr bool cq_is_u(int p) { return p >= 1 && (((p - 1) % 17) == 5 || ((p - 1) % 17) == 13); }
__host__ __device__ constexpr int cq_min(int a, int b) { return a < b ? a : b; }
__host__ __device__ constexpr int cq_max(int a, int b) { return a > b ? a : b; }
__host__ __device__ constexpr int cq_frontier(int p, int what) {
    int F = convq_need(1);
    for (int k = 1; k <= p; ++k) {
        if (k == p && what == 0) return F;
        if (cq_is_q(k)) F = cq_min(F + CQ_CAPQ, CQ_TOTAL); else if (cq_is_u(k)) F = cq_min(F + CQ_CAPU, CQ_TOTAL);
        if (k == p) return F;
        F = cq_max(F, convq_need(k + 1));
    }
    return F;
}
__device__ __noinline__ void convq_range(LAS unsigned char* lds, int lo, int hi, int rank, int stride, int sync, const float* wqkv, const float* wo, const float* win, const float* wglu, const float* wup, const float* wdn, unsigned char* ws) {
    if (sync) __syncthreads();
    const int lane = threadIdx.x & 63, wave = __builtin_amdgcn_readfirstlane(threadIdx.x >> 6);
    for (int it = lo + rank; it < hi; it += stride) convq_process(lds, wave, lane, it, wqkv, wo, win, wglu, wup, wdn, ws);
}
#define CONVQ_RANGE(lo, hi, rank, stride, sync) convq_range(c.lds, (lo), (hi), (rank), (stride), (sync), args.in[I_WQKV], args.in[I_WO], args.in[I_WIN], args.in[I_WGLU], args.in[I_WUP], args.in[I_WDN], args.ws)
#define CONVQ_SEAM(k) do { constexpr int lo_ = cq_frontier((k), 1), hi_ = convq_need((k) + 1); if (lo_ < hi_) CONVQ_RANGE(lo_, hi_, c.vcu * NWAVES + c.wave, c.G * NWAVES, 1); } while (0)
#define CONVQ_TAIL(p, nbusy, cap) do { constexpr int lo_ = cq_frontier((p), 0), hi_ = cq_min(lo_ + (cap), CQ_TOTAL); \
    if (CONV_TAILS && lo_ < hi_ && (int)blockIdx.x >= (nbusy)) CONVQ_RANGE(lo_, hi_, ((int)blockIdx.x - (nbusy)) * NWAVES + c.wave, ((int)gridDim.x - (nbusy)) * NWAVES, 0); } while (0)
__device__ __forceinline__ void build_cs(const Ctx& c, float* cs) {
    const int gt = (c.vcu * NWAVES + c.wave) * 64 + c.lane, NT = c.G * NWAVES * 64;
    for (int idx = gt; idx < 2049 * 16; idx += NT) {
        const int t = idx >> 4, i = idx & 15;
        const float pos = (t < 2048) ? (float)t : 16384.0f;
        const float inv = __builtin_amdgcn_exp2f(-18.931568569324174f * (float)i * 0.0625f);
        float s, co; sincos_rr(pos * inv, s, co);
        cs[t * 32 + i] = co; cs[t * 32 + 16 + i] = s;
    }
}
__device__ __forceinline__ void prenorm_rows(const Ctx& c, int nrows, const float* x, const float* g, bf16* H) {
    const int gw = c.vcu * NWAVES + c.wave, NGW = c.G * NWAVES;
    if (gw >= nrows) return;
    f32x4 gv[8], xn[8];
#pragma unroll
    for (int j = 0; j < 8; ++j) { gv[j] = *(const f32x4*)(g + 4 * c.lane + 256 * j); xn[j] = *(const f32x4*)(x + (size_t)gw * D + 4 * c.lane + 256 * j); }
    for (int row = gw; row < nrows; row += NGW) {
        f32x4 v[8]; float ss = 0.f;
#pragma unroll
        for (int j = 0; j < 8; ++j) { v[j] = xn[j]; ss += (v[j].x * v[j].x + v[j].y * v[j].y) + (v[j].z * v[j].z + v[j].w * v[j].w); }
        if (row + NGW < nrows) {
#pragma unroll
            for (int j = 0; j < 8; ++j) xn[j] = *(const f32x4*)(x + (size_t)(row + NGW) * D + 4 * c.lane + 256 * j); }
        const float rstd = 1.0f / sqrtf(wave_sum(ss) * (1.0f / D) + RMS_EPS);
#pragma unroll
        for (int j = 0; j < 8; ++j) { const f32x4 h = v[j] * rstd * gv[j];
            u32x2 w; w.x = pk2(h.x, h.y); w.y = pk2(h.z, h.w); *(u32x2*)(H + (size_t)row * D + 4 * c.lane + 256 * j) = w; }
    }
}
template <bool GLU, bool ZERO_M = false, bool MBF = false> __device__ __forceinline__ void postnorm_rows(const Ctx& c, int nrows, const float* xin, float* xout, const float* M, int ldm, const float* g1, const float* g2, bf16* H, float mscale = 1.0f) {
    const int gw = c.vcu * NWAVES + c.wave, NGW = c.G * NWAVES;
    if (gw >= nrows) return;
    f32x4 ga[8], gb[8];
#pragma unroll
    for (int j = 0; j < 8; ++j) { const int col = 4 * c.lane + 256 * j; ga[j] = *(const f32x4*)(g1 + col); gb[j] = g2 ? *(const f32x4*)(g2 + col) : (f32x4){0.f, 0.f, 0.f, 0.f}; }
    f32x4 v[8], xv[8]; u32x2 mw[8];
    auto load_row = [&](int row) {
        const float* mr = M + (size_t)row * ldm;
#pragma unroll
        for (int j = 0; j < 8; ++j) { const int col = 4 * c.lane + 256 * j;
            if (MBF) mw[j] = *(const u32x2*)((const bf16*)M + (size_t)row * ldm + col);
            else if (!GLU) { v[j] = *(const f32x4*)(mr + col); if (ZERO_M) *(f32x4*)const_cast<float*>(mr + col) = (f32x4){0.f, 0.f, 0.f, 0.f}; }
            else { const float* pa = mr + (col >> 7) * 256 + (col & 127); const f32x4 a = *(const f32x4*)pa, gt = *(const f32x4*)(pa + 128);
                if (ZERO_M) { *(f32x4*)const_cast<float*>(pa) = (f32x4){0.f, 0.f, 0.f, 0.f}; *(f32x4*)const_cast<float*>(pa + 128) = (f32x4){0.f, 0.f, 0.f, 0.f}; }
                v[j].x = a.x * sigmoidf_(gt.x); v[j].y = a.y * sigmoidf_(gt.y); v[j].z = a.z * sigmoidf_(gt.z); v[j].w = a.w * sigmoidf_(gt.w); }
            xv[j] = *(const f32x4*)(xin + (size_t)row * D + col); }
    };
    load_row(gw);
    for (int row = gw; row < nrows; row += NGW) {
        f32x4 xc[8]; u32x2 mc[8]; float ss = 0.f;
#pragma unroll
        for (int j = 0; j < 8; ++j) { if (MBF) mc[j] = mw[j]; else xc[j] = v[j];
            const f32x4 y = MBF ? (f32x4){bflo(mc[j].x), bfhi(mc[j].x), bflo(mc[j].y), bfhi(mc[j].y)} : xc[j];
            ss += (y.x * y.x + y.y * y.y) + (y.z * y.z + y.w * y.w); }
        f32x4 xo[8];
#pragma unroll
        for (int j = 0; j < 8; ++j) xo[j] = xv[j];
        if (MBF && row + NGW < nrows) load_row(row + NGW);
        const float rstd = 1.0f / sqrtf(wave_sum(ss) * (1.0f / D) + RMS_EPS);
        float ss2 = 0.f;
#pragma unroll
        for (int j = 0; j < 8; ++j) { const int col = 4 * c.lane + 256 * j;
            const f32x4 y = MBF ? (f32x4){bflo(mc[j].x), bfhi(mc[j].x), bflo(mc[j].y), bfhi(mc[j].y)} : xc[j];
            const f32x4 xn = xo[j] + y * (rstd * mscale) * ga[j]; *(f32x4*)(xout + (size_t)row * D + col) = xn; xo[j] = xn;
            ss2 += (xn.x * xn.x + xn.y * xn.y) + (xn.z * xn.z + xn.w * xn.w); }
        if (g2) {
            const float rstd2 = 1.0f / sqrtf(wave_sum(ss2) * (1.0f / D) + RMS_EPS);
#pragma unroll
            for (int j = 0; j < 8; ++j) { const int col = 4 * c.lane + 256 * j; const f32x4 h = xo[j] * rstd2 * gb[j];
                u32x2 w; w.x = pk2(h.x, h.y); w.y = pk2(h.z, h.w); *(u32x2*)(H + (size_t)row * D + col) = w; }
        }
    }
}


__device__ __forceinline__ void skinny_gemm(const Ctx& c, const bf16* A, const bf16* Bt, int N, int K, float* out, int first_wg = 0) {
    const int nks = K / 32, ncg = N / 16;
    const int cq = c.lane & 15, rq = c.lane >> 4;
    if ((int)blockIdx.x < first_wg) return;
    const int nw = c.G - first_wg, me = first_wg ? (int)blockIdx.x - first_wg : c.vcu;
    for (int it = c.wave * nw + me; it < ncg * 8; it += nw * NWAVES) {
        const int cg = it >> 3, kp = it & 7, ks0 = (kp * nks) >> 3, ks1 = ((kp + 1) * nks) >> 3;
        const bf16* bp = Bt + (size_t)(16 * cg + cq) * K + 8 * rq; const bf16* ap = A + (size_t)(cq & 7) * K + 8 * rq;
        f32x4 acc = (f32x4){0.f, 0.f, 0.f, 0.f};
#pragma unroll 4
        for (int ks = ks0; ks < ks1; ++ks) acc = __builtin_amdgcn_mfma_f32_16x16x32_bf16(*(const bf16x8*)(bp + 32 * ks), *(const bf16x8*)(ap + 32 * ks), acc, 0, 0, 0);
        if (cq < 8) { float* o = out + (size_t)cq * N + 16 * cg + 4 * rq;
#pragma unroll
            for (int e = 0; e < 4; ++e) unsafeAtomicAdd(o + e, acc[e]); }
    }
}
__device__ __forceinline__ void zero_f32(const Ctx& c, float* p, int n) {
    const int gt = (c.vcu * NWAVES + c.wave) * 64 + c.lane, NT = c.G * NWAVES * 64;
    for (int i = gt; i < n; i += NT) p[i] = 0.f;
}

constexpr int AT_KP = 272, AT_VP = 528, AT_VOFF = 256 * AT_KP;
struct AttnItem { int g, dsh, r, qt, bgh, base, row0; };
__device__ __forceinline__ AttnItem attn_item(int it) {
    AttnItem a; const int bh = it / 48, rem = it - bh * 48, sub = rem & 15, b = bh >> 3, h = bh & 7;
    a.g = rem >> 4; a.dsh = 2 * a.g; a.r = sub >> (4 - a.dsh); a.qt = sub & ((16 >> a.dsh) - 1);
    a.bgh = (b * 3 + a.g) * 8 + h; a.base = a.r * (2048 >> a.dsh); a.row0 = b * 2048; return a;
}
__device__ __forceinline__ void attn_stage_load(const AttnItem& a, const bf16* K, const bf16* V, int tid, u32x4 (&kr)[8], u32x4 (&vr)[8]) {
    const bf16* Kp = K + (size_t)a.bgh * 2048 * 128; const bf16* Vp = V + (size_t)a.bgh * 2048 * 128;
    const int kw0 = 128 * a.qt - 128, c16 = tid & 15, o = tid >> 4;
#pragma unroll
    for (int i = 0; i < 8; ++i) { int ks = kw0 + 32 * i + o; ks = ks < 0 ? 0 : ks;
        kr[i] = *(const u32x4*)(Kp + (size_t)(a.base + ks) * 128 + 8 * c16);
        int kv = kw0 + 8 * o + i; kv = kv < 0 ? 0 : kv;
        vr[i] = *(const u32x4*)(Vp + (size_t)(a.base + kv) * 128 + 8 * c16); }
}
__device__ __forceinline__ void attn_stage_store(LAS unsigned char* lds, int tid, const u32x4 (&kr)[8], const u32x4 (&vr)[8]) {
    const int c16 = tid & 15, o = tid >> 4;
#pragma unroll
    for (int i = 0; i < 8; ++i) *(LAS u32x4*)(lds + (32 * i + o) * AT_KP + 16 * c16) = kr[i];
#pragma unroll
    for (int e = 0; e < 8; ++e) { const unsigned sel = (e & 1) ? 0x07060302u : 0x05040100u; u32x4 w;
#pragma unroll
        for (int m = 0; m < 4; ++m) w[m] = __builtin_amdgcn_perm(vr[2 * m + 1][e >> 1], vr[2 * m][e >> 1], sel);
        *(LAS u32x4*)(lds + AT_VOFF + (8 * c16 + e) * AT_VP + 16 * (o ^ (c16 & 7))) = w; }
}
__device__ __forceinline__ void attn_prompt(const Ctx& c, const bf16* Q, const bf16* K, const bf16* VT, bf16* OG, float* LSE, float* LL) {
    const int cq = c.lane & 15, rq = c.lane >> 4, w = c.wave;
    u32x4 kr[8], vr[8]; bf16x8 qn[4];
    int it = c.vcu;
    if (it < 1536) { const AttnItem a0 = attn_item(it); attn_stage_load(a0, K, VT, c.tid, kr, vr);
#pragma unroll
        for (int ks = 0; ks < 4; ++ks) qn[ks] = *(const bf16x8*)(Q + ((size_t)a0.bgh * 2048 + a0.base + 128 * a0.qt + 16 * w + cq) * 128 + 32 * ks + 8 * rq); }
    for (; it < 1536; it += c.G) {
        const AttnItem a = attn_item(it);
        attn_stage_store(c.lds, c.tid, kr, vr);
        bf16x8 qf[4];
#pragma unroll
        for (int ks = 0; ks < 4; ++ks) qf[ks] = qn[ks];
        __syncthreads();
        if (it + c.G < 1536) { const AttnItem an = attn_item(it + c.G); attn_stage_load(an, K, VT, c.tid, kr, vr);
#pragma unroll
            for (int ks = 0; ks < 4; ++ks) qn[ks] = *(const bf16x8*)(Q + ((size_t)an.bgh * 2048 + an.base + 128 * an.qt + 16 * w + cq) * 128 + 32 * ks + 8 * rq); }
        const int dsh = a.dsh, g = a.g;
        const int s0 = 128 * a.qt + 16 * w, kb = s0 - 128;
        f32x4 st[9];
#pragma unroll
        for (int j = 0; j < 9; ++j) {
            const int krow = 16 * w + (j < 8 ? 32 * (j >> 1) + 8 * (cq >> 2) + 4 * (j & 1) + (cq & 3) : 128 + cq);
            const LAS unsigned char* kl = c.lds + krow * AT_KP + 16 * rq;
            f32x4 acc = (f32x4){0.f, 0.f, 0.f, 0.f};
#pragma unroll
            for (int ks = 0; ks < 4; ++ks) acc = __builtin_amdgcn_mfma_f32_16x16x32_bf16(*(const LAS bf16x8*)(kl + 64 * ks), qf[ks], acc, 0, 0, 0);
            st[j] = acc;
        }
        const int qs = s0 + cq, lo = (qs - 128) < 0 ? 0 : (qs - 128);
        float mx = -1e30f;
#pragma unroll
        for (int j = 0; j < 9; ++j)
#pragma unroll
            for (int e = 0; e < 4; ++e) { const int ksub = kb + (j < 8 ? 32 * (j >> 1) + 8 * rq + 4 * (j & 1) + e : 128 + 4 * rq + e); const bool ok = (ksub >= lo) && (ksub <= qs);
                const float v = ok ? st[j][e] : -1e30f; st[j][e] = v; mx = fmaxf(mx, v); }
        mx = fmaxf(mx, __shfl_xor(mx, 16)); mx = fmaxf(mx, __shfl_xor(mx, 32));
        float l = 0.f;
#pragma unroll
        for (int j = 0; j < 9; ++j)
#pragma unroll
            for (int e = 0; e < 4; ++e) { const float pv = __builtin_amdgcn_exp2f(st[j][e] - mx); st[j][e] = pv; l += pv; }
        l += __shfl_xor(l, 16); l += __shfl_xor(l, 32);
        bf16x8 pf[4];
#pragma unroll
        for (int p = 0; p < 4; ++p) { u32x4 wv; wv.x = pk2(st[2 * p][0], st[2 * p][1]); wv.y = pk2(st[2 * p][2], st[2 * p][3]); wv.z = pk2(st[2 * p + 1][0], st[2 * p + 1][1]); wv.w = pk2(st[2 * p + 1][2], st[2 * p + 1][3]);
            pf[p] = __builtin_bit_cast(bf16x8, wv); }
        u32x2 w8; w8.x = pk2(st[8][0], st[8][1]); w8.y = pk2(st[8][2], st[8][3]);
        const bf16x4 pf8 = __builtin_bit_cast(bf16x4, w8);
        const float rl = 1.0f / l;
        const int row = a.row0 + ((s0 + cq) << dsh) + a.r, h = a.bgh & 7;
        bf16* orow = OG + ((size_t)g * MP + row) * AW + h * 128 + 4 * rq;
#pragma unroll
        for (int i = 0; i < 8; ++i) {
            f32x4 acc = (f32x4){0.f, 0.f, 0.f, 0.f};
            const LAS unsigned char* vl = c.lds + AT_VOFF + (16 * i + cq) * AT_VP; const int swz = (2 * i + (cq >> 3)) & 7;
#pragma unroll
            for (int p = 0; p < 4; ++p) acc = __builtin_amdgcn_mfma_f32_16x16x32_bf16(*(const LAS bf16x8*)(vl + 16 * ((2 * w + 4 * p + rq) ^ swz)), pf[p], acc, 0, 0, 0);
            acc = __builtin_amdgcn_mfma_f32_16x16x16bf16_1k(*(const LAS bf16x4*)(vl + 16 * ((2 * w + 16 + (rq >> 1)) ^ swz) + 8 * (rq & 1)), pf8, acc, 0, 0, 0);
            u32x2 wv; wv.x = pk2(acc[0] * rl, acc[1] * rl); wv.y = pk2(acc[2] * rl, acc[3] * rl);
            *(u32x2*)(orow + 16 * i) = wv;
        }
        if (rq == 0) { LSE[((size_t)g * MP + row) * 8 + h] = (mx + __builtin_amdgcn_logf(l)) * 0.6931471805599453f; LL[((size_t)g * MP + row) * 8 + h] = l; }
        __syncthreads();
    }
}
__device__ __forceinline__ void merge_prompt(const Ctx& c, const bf16* OG, const float* LSE, const float* LL, bf16* O) {
    const int gw = c.vcu * NWAVES + c.wave, NGW = c.G * NWAVES, head = c.lane >> 3;
    u32x4 og[3][2]; float ls[3], lh[3], lz[3];
    auto load_row = [&](int row) {
#pragma unroll
        for (int gi = 0; gi < 3; ++gi) { const size_t i = ((size_t)gi * MP + row) * 8; ls[gi] = LSE[i + head]; lh[gi] = LL[i + head]; lz[gi] = LL[i];
#pragma unroll
            for (int hf = 0; hf < 2; ++hf) og[gi][hf] = *(const u32x4*)(OG + ((size_t)gi * MP + row) * AW + 16 * c.lane + 8 * hf); }
    };
    if (gw < MP) load_row(gw);
    for (int row = gw; row < MP; row += NGW) {
        u32x4 a[2], bq[2], cc[2];
#pragma unroll
        for (int hf = 0; hf < 2; ++hf) { a[hf] = og[0][hf]; bq[hf] = og[1][hf]; cc[hf] = og[2][hf]; }
        const float l0 = ls[0], l1 = ls[1], l2 = ls[2];
        const float m = fmaxf(l0, fmaxf(l1, l2)); float w0 = __expf(l0 - m), w1 = __expf(l1 - m), w2 = __expf(l2 - m); const float inv = 1.0f / (w0 + w1 + w2);
        w0 *= inv * lh[0] / lz[0]; w1 *= inv * lh[1] / lz[1]; w2 *= inv * lh[2] / lz[2];
        if (row + NGW < MP) load_row(row + NGW);
#pragma unroll
        for (int hf = 0; hf < 2; ++hf) { const int col = 16 * c.lane + 8 * hf;
            u32x4 o;
#pragma unroll
            for (int e = 0; e < 4; ++e) { const float lo = w0 * bflo(a[hf][e]) + w1 * bflo(bq[hf][e]) + w2 * bflo(cc[hf][e]), hi = w0 * bfhi(a[hf][e]) + w1 * bfhi(bq[hf][e]) + w2 * bfhi(cc[hf][e]); o[e] = pk2(lo, hi); }
            *(u32x4*)(O + (size_t)row * AW + col) = o; }
    }
}

template <int GG> __device__ __forceinline__ void attn_sample(const Ctx& c, int li, const float* QKVS, const float* cs, const float* ck, float* OSG, float* LSES, float* kvsb) {
    LAS float* sh = (LAS float*)c.lds;
    const float* csr = cs + 2048 * 32;
    constexpr int g = GG, dil = 1 << (2 * GG), L = 128 << (2 * GG);
    for (int it = c.vcu - 64 * GG; it >= 0 && it < 64; it += c.G) {
        const int b = it >> 3, h = it & 7;
        const float* cache = ck + ((size_t)(li * 8 + b) * L) * 2048;
        float* kvs = kvsb + (size_t)(li * 8 + b) * 2048;
        const float* qrow = QKVS + (size_t)b * NQKV + g * 1024 + h * 128;
        if (c.tid < 128) { const int d = c.tid;
            float qv = qrow[d], kv = qrow[3072 + d]; const float vv = qrow[6144 + d];
            if (d < 16) { const float co = csr[d], si = csr[16 + d]; const float q2 = qrow[d + 16], k2 = qrow[3072 + d + 16]; qv = qv * co - q2 * si; kv = kv * co - k2 * si; }
            else if (d < 32) { const float co = csr[d - 16], si = csr[d]; const float q1 = qrow[d - 16], k1 = qrow[3072 + d - 16]; qv = qv * co + q1 * si; kv = kv * co + k1 * si; }
            sh[d] = qv * 0.08838834764831845f; sh[128 + d] = kv; sh[256 + d] = vv;
            kvs[h * 128 + d] = kv; kvs[1024 + h * 128 + d] = vv; }
        __syncthreads();
        if (c.tid < 128) { float* qz = const_cast<float*>(qrow); qz[c.tid] = 0.f; qz[3072 + c.tid] = 0.f; qz[6144 + c.tid] = 0.f; }
        const f32x2 q2 = *(const LAS f32x2*)(sh + 2 * c.lane);
        float m = -1e30f, l = 0.f; f32x2 acc = (f32x2){0.f, 0.f};
        f32x2 kk[17], vv[17];
#pragma unroll
        for (int t = 0; t < 17; ++t) { const int jj = c.wave + 8 * t;
            if (jj == 0) { kk[t] = *(const LAS f32x2*)(sh + 128 + 2 * c.lane); vv[t] = *(const LAS f32x2*)(sh + 256 + 2 * c.lane); }
            else { const int jc = jj <= 128 ? jj : 128; const float* rp = cache + (size_t)(L - dil * jc) * 2048 + h * 128 + 2 * c.lane; kk[t] = *(const f32x2*)rp; vv[t] = *(const f32x2*)(rp + 1024); } }
        float sc_[17];
#pragma unroll
        for (int t = 0; t < 17; ++t) sc_[t] = q2.x * kk[t].x + q2.y * kk[t].y;
#pragma unroll
        for (int o = 1; o < 64; o <<= 1)
#pragma unroll
            for (int t = 0; t < 17; ++t) sc_[t] += __shfl_xor(sc_[t], o);
#pragma unroll
        for (int t = 0; t < 17; ++t) { const int jj = c.wave + 8 * t;
            if (jj <= 128) {
                const float s = sc_[t];
                const float mn = fmaxf(m, s), sc = __expf(m - mn), pe = __expf(s - mn);
                l = l * sc + pe; acc = acc * sc + vv[t] * pe; m = mn; } }
        LAS float* pw = sh + 512 + c.wave * 132;
        if (c.lane == 0) { pw[0] = m; pw[1] = l; }
        *(LAS f32x2*)(pw + 4 + 2 * c.lane) = acc;
        __syncthreads();
        if (c.wave == 0) {
            float M = -1e30f;
#pragma unroll
            for (int w = 0; w < 8; ++w) M = fmaxf(M, sh[512 + w * 132]);
            float Lt = 0.f; f32x2 o = (f32x2){0.f, 0.f};
#pragma unroll
            for (int w = 0; w < 8; ++w) { const float f = __expf(sh[512 + w * 132] - M); Lt += sh[512 + w * 132 + 1] * f; o += *(const LAS f32x2*)(sh + 512 + w * 132 + 4 + 2 * c.lane) * f; }
            const float rl = 1.0f / Lt;
            *(f32x2*)(OSG + ((size_t)g * 8 + b) * 1024 + h * 128 + 2 * c.lane) = o * rl;
            if (c.lane == 0) { LSES[(g * 8 + b) * 8 + h] = M + __logf(Lt); LSES[256 + (g * 8 + b) * 8 + h] = Lt; }
        }
        __syncthreads();
    }
}
__device__ __forceinline__ void merge_sample(const Ctx& c, const float* OSG, const float* LSES, bf16* OS) {
    if (c.vcu != 0) return;
    const int b = c.wave, head = c.lane >> 3;
    const float l0 = LSES[(0 * 8 + b) * 8 + head], l1 = LSES[(1 * 8 + b) * 8 + head], l2 = LSES[(2 * 8 + b) * 8 + head];
    const float m = fmaxf(l0, fmaxf(l1, l2)); float w0 = __expf(l0 - m), w1 = __expf(l1 - m), w2 = __expf(l2 - m); const float inv = 1.0f / (w0 + w1 + w2);
    w0 *= inv * LSES[256 + (0 * 8 + b) * 8 + head] / LSES[256 + (0 * 8 + b) * 8]; w1 *= inv * LSES[256 + (1 * 8 + b) * 8 + head] / LSES[256 + (1 * 8 + b) * 8]; w2 *= inv * LSES[256 + (2 * 8 + b) * 8 + head] / LSES[256 + (2 * 8 + b) * 8];
#pragma unroll
    for (int e = 0; e < 16; e += 2) { const int col = 16 * c.lane + e;
        const float lo = w0 * OSG[(0 * 8 + b) * 1024 + col] + w1 * OSG[(1 * 8 + b) * 1024 + col] + w2 * OSG[(2 * 8 + b) * 1024 + col];
        const float hi = w0 * OSG[(0 * 8 + b) * 1024 + col + 1] + w1 * OSG[(1 * 8 + b) * 1024 + col + 1] + w2 * OSG[(2 * 8 + b) * 1024 + col + 1];
        *(unsigned*)(OS + (size_t)b * 1024 + col) = pk2(lo, hi); }
}

__device__ __forceinline__ void conv_prompt(const Ctx& c, const bf16* U, bf16* ACT, const float* cw, const float* cb, float* convp) {
    const int gw = c.vcu * NWAVES + c.wave, NGW = c.G * NWAVES, cl = c.lane & 15, rg = c.lane >> 4;
    for (int it = gw; it < 128 * 43; it += NGW) {
        const int rb = it / 43, pn = it - rb * 43;
        const int gcol = 128 * pn + 8 * cl, vcol = FF + gcol;
        float wg[3][8], wv[3][8], bg[8], bv[8];
#pragma unroll
        for (int e = 0; e < 8; ++e) { bg[e] = cb[gcol + e]; bv[e] = cb[vcol + e];
#pragma unroll
            for (int j = 0; j < 3; ++j) { wg[j][e] = cw[j * FF2 + gcol + e]; wv[j][e] = cw[j * FF2 + vcol + e]; } }
        const int row0 = rb * 64 + rg * 16;
        float g1[8], g2[8], v1[8], v2[8];
#pragma unroll
        for (int e = 0; e < 8; ++e) { g1[e] = 0.f; g2[e] = 0.f; v1[e] = 0.f; v2[e] = 0.f; }
        if ((row0 & 2047) != 0) {
            const u32x4 a1 = *(const u32x4*)(U + (size_t)(row0 - 1) * FF2 + 256 * pn + 8 * cl), b1 = *(const u32x4*)(U + (size_t)(row0 - 1) * FF2 + 256 * pn + 128 + 8 * cl);
            const u32x4 a2 = *(const u32x4*)(U + (size_t)(row0 - 2) * FF2 + 256 * pn + 8 * cl), b2 = *(const u32x4*)(U + (size_t)(row0 - 2) * FF2 + 256 * pn + 128 + 8 * cl);
#pragma unroll
            for (int e = 0; e < 4; ++e) { g1[2 * e] = bflo(a1[e]); g1[2 * e + 1] = bfhi(a1[e]); v1[2 * e] = bflo(b1[e]); v1[2 * e + 1] = bfhi(b1[e]);
                g2[2 * e] = bflo(a2[e]); g2[2 * e + 1] = bfhi(a2[e]); v2[2 * e] = bflo(b2[e]); v2[2 * e + 1] = bfhi(b2[e]); }
        }
        for (int rr = 0; rr < 16; ++rr) {
            const int row = row0 + rr;
            const u32x4 a0 = *(const u32x4*)(U + (size_t)row * FF2 + 256 * pn + 8 * cl), b0 = *(const u32x4*)(U + (size_t)row * FF2 + 256 * pn + 128 + 8 * cl);
            float g0[8], v0[8], act[8];
#pragma unroll
            for (int e = 0; e < 4; ++e) { g0[2 * e] = bflo(a0[e]); g0[2 * e + 1] = bfhi(a0[e]); v0[2 * e] = bflo(b0[e]); v0[2 * e + 1] = bfhi(b0[e]); }
#pragma unroll
            for (int e = 0; e < 8; ++e) { const float cg = bg[e] + wg[0][e] * g2[e] + wg[1][e] * g1[e] + wg[2][e] * g0[e], cv = bv[e] + wv[0][e] * v2[e] + wv[1][e] * v1[e] + wv[2][e] * v0[e];
                act[e] = cg * sigmoidf_(cg) * cv; g2[e] = g1[e]; g1[e] = g0[e]; v2[e] = v1[e]; v1[e] = v0[e]; }
            u32x4 o; o.x = pk2(act[0], act[1]); o.y = pk2(act[2], act[3]); o.z = pk2(act[4], act[5]); o.w = pk2(act[6], act[7]);
            *(u32x4*)(ACT + (size_t)row * FF + gcol) = o;
            const int t = row & 2047;
            if (t >= 2046) { float* o1 = convp + ((size_t)(row >> 11) * 2 + (t - 2046)) * FF2;
#pragma unroll
                for (int e = 0; e < 8; ++e) { o1[gcol + e] = g0[e]; o1[vcol + e] = v0[e]; } }
        }
    }
}
__device__ __forceinline__ void conv_sample(const Ctx& c, const float* US, const float* st, bf16* ACTS, const float* cw, const float* cb, float* convs) {
    const int gt = (c.vcu * NWAVES + c.wave) * 64 + c.lane, NT = c.G * NWAVES * 64;
    for (int idx = gt; idx < 8 * FF; idx += NT) {
        const int b = idx / FF, j = idx - b * FF, pn = j >> 7, jj = j & 127;
        const float ug = US[(size_t)b * FF2 + 256 * pn + jj], uv = US[(size_t)b * FF2 + 256 * pn + 128 + jj];
        { float* uz = const_cast<float*>(US); uz[(size_t)b * FF2 + 256 * pn + jj] = 0.f; uz[(size_t)b * FF2 + 256 * pn + 128 + jj] = 0.f; }
        const float* s0 = st + (size_t)b * 2 * FF2; const float* s1 = s0 + FF2;
        const float cg = cb[j] + cw[j] * s0[j] + cw[FF2 + j] * s1[j] + cw[2 * FF2 + j] * ug;
        const float cv = cb[FF + j] + cw[FF + j] * s0[FF + j] + cw[FF2 + FF + j] * s1[FF + j] + cw[2 * FF2 + FF + j] * uv;
        ACTS[(size_t)b * FF + j] = (bf16)(pk2(cg * sigmoidf_(cg) * cv, 0.f) & 0xffffu);
        float* o = convs + (size_t)b * 2 * FF2; o[j] = s1[j]; o[FF + j] = s1[FF + j]; o[FF2 + j] = ug; o[FF2 + FF + j] = uv;
    }
}


__device__ __forceinline__ void conv_fixup(const Ctx& c, const float* part, const float* halou, bf16* ACT, const float* cw) {
    const int gt = (c.vcu * NWAVES + c.wave) * 64 + c.lane, NT = c.G * NWAVES * 64;
    for (int idx = gt; idx < 32 * 2 * FF; idx += NT) {
        const int pm = idx / (2 * FF), rem = idx - pm * 2 * FF, r = rem / FF, j = rem - r * FF, pn = j >> 7, jj = j & 127;
        if ((pm & 7) == 0) continue;
        const size_t ci = 256 * pn + jj;
        float cg = part[((size_t)pm * 2 + r) * FF2 + ci], cv = part[((size_t)pm * 2 + r) * FF2 + ci + 128];
        const float ug2 = halou[((size_t)(pm - 1) * 2 + 0) * FF2 + ci], ug1 = halou[((size_t)(pm - 1) * 2 + 1) * FF2 + ci];
        const float uv2 = halou[((size_t)(pm - 1) * 2 + 0) * FF2 + ci + 128], uv1 = halou[((size_t)(pm - 1) * 2 + 1) * FF2 + ci + 128];
        if (r == 0) { cg += cw[j] * ug2 + cw[FF2 + j] * ug1; cv += cw[FF + j] * uv2 + cw[FF2 + FF + j] * uv1; }
        else { cg += cw[j] * ug1; cv += cw[FF + j] * uv1; }
        ACT[((size_t)pm * 256 + r) * FF + j] = (bf16)(pk2(cg * sigmoidf_(cg) * cv, 0.f) & 0xffffu);
    }
}

__device__ __forceinline__ void ssm_prompt(const Ctx& c, const bf16* US, bf16* Z, const float* lam_re, const float* lam_im, const float* log_dt, const float* b_re, const float* b_im,
                                           const float* c_re, const float* c_im, const float* d_skip, float* ssm_out) {
    const int lane = c.lane, cq = lane & 15, rq = lane >> 4, sq = c.wave >> 2, q = c.wave & 3;
    LAS unsigned* BU = (LAS unsigned*)(c.lds + c.wave * 12544);
    LAS unsigned char* XL = c.lds + c.wave * 12544 + 8192;
    LAS f32x2* EX = (LAS f32x2*)(c.lds + 8 * 12544);
    for (int it0 = c.vcu; it0 < 256; it0 += c.G) {
        const int it = sq * 256 + it0, b = it >> 7, g = it & 127;
        const float lr = fminf(lam_re[g * 64 + lane], -1e-4f), lim = lam_im[g * 64 + lane], dt = __expf(log_dt[g]);
        const float mag = __expf(lr * dt); float sn, cs_; sincos_rr(lim * dt, sn, cs_);
        const float ar = mag * cs_, ai = mag * sn;
        const float den = 1.0f / (lr * lr + lim * lim), nr = ar - 1.0f;
        const float cr = (nr * lr + ai * lim) * den, ci = (ai * lr - nr * lim) * den;
        bf16x4 bb[8];
#pragma unroll
        for (int jn = 0; jn < 8; ++jn) { const int pp = 16 * (jn & 3) + cq; const float crr = __shfl(cr, pp), cii = __shfl(ci, pp);
            const f32x4 br = *(const f32x4*)(b_re + (size_t)(g * 64 + pp) * 16 + 4 * rq), bi = *(const f32x4*)(b_im + (size_t)(g * 64 + pp) * 16 + 4 * rq);
            float v[4];
#pragma unroll
            for (int e = 0; e < 4; ++e) v[e] = (jn >= 4) ? (crr * bi[e] + cii * br[e]) : (crr * br[e] - cii * bi[e]);
            u32x2 wv; wv.x = pk2(v[0], v[1]); wv.y = pk2(v[2], v[3]); bb[jn] = __builtin_bit_cast(bf16x4, wv); }
        const size_t rowbase = (size_t)b * 2048 + 512 * q;
        float xr = 0.f, xi = 0.f;
        const bf16* up0 = US + (rowbase + cq) * 2048 + 16 * g + 4 * rq;
        bf16x4 ua = *(const bf16x4*)up0, ub = *(const bf16x4*)(up0 + (size_t)16 * 2048);
        for (int ch = 0; ch < 32; ++ch) {
            const bf16x4 ua_n = *(const bf16x4*)(up0 + (size_t)(ch < 30 ? ch + 2 : 31) * 16 * 2048);
#pragma unroll
            for (int jn = 0; jn < 4; ++jn) { f32x4 dr = __builtin_amdgcn_mfma_f32_16x16x16bf16_1k(ua, bb[jn], (f32x4){0.f, 0.f, 0.f, 0.f}, 0, 0, 0), di = __builtin_amdgcn_mfma_f32_16x16x16bf16_1k(ua, bb[jn + 4], (f32x4){0.f, 0.f, 0.f, 0.f}, 0, 0, 0);
#pragma unroll
                for (int e = 0; e < 4; ++e) BU[(4 * rq + e) * 64 + 16 * jn + cq] = pk2v(dr[e], di[e]); }
            LDS_WAIT();
#pragma unroll
            for (int tt = 0; tt < 16; ++tt) { const unsigned bw = BU[tt * 64 + lane]; const f32x2 bu = (f32x2){bflo(bw), bfhi(bw)};
                const float nxr = __builtin_fmaf(ar, xr, __builtin_fmaf(-ai, xi, bu.x)), nxi = __builtin_fmaf(ar, xi, __builtin_fmaf(ai, xr, bu.y)); xr = nxr; xi = nxi; }
            LDS_WAIT();
            ua = ub; ub = ua_n;
        }
        EX[(sq * 4 + q) * 64 + lane] = (f32x2){xr, xi};
        __syncthreads();
        float pr = ar, pi = ai;
#pragma unroll
        for (int k = 0; k < 9; ++k) { const float t = pr * pr - pi * pi; pi = 2.0f * pr * pi; pr = t; }
        xr = 0.f; xi = 0.f;
        for (int qq = 0; qq < q; ++qq) { const f32x2 e = EX[(sq * 4 + qq) * 64 + lane]; const float nxr = pr * xr - pi * xi + e.x, nxi = pr * xi + pi * xr + e.y; xr = nxr; xi = nxi; }
        bf16x8 cf[4];
#pragma unroll
        for (int ks = 0; ks < 4; ++ks) { const f32x4 cre = *(const f32x4*)(c_re + (size_t)(g * 16 + cq) * 64 + 16 * ks + 4 * rq), cim = *(const f32x4*)(c_im + (size_t)(g * 16 + cq) * 64 + 16 * ks + 4 * rq);
            u32x4 wv; wv.x = pk2(cre[0], -cim[0]); wv.y = pk2(cre[1], -cim[1]); wv.z = pk2(cre[2], -cim[2]); wv.w = pk2(cre[3], -cim[3]); cf[ks] = __builtin_bit_cast(bf16x8, wv); }
        const f32x4 dsk = *(const f32x4*)(d_skip + 16 * g + 4 * rq);
        ua = *(const bf16x4*)up0; ub = *(const bf16x4*)(up0 + (size_t)16 * 2048);
        for (int ch = 0; ch < 32; ++ch) {
            const size_t off = (rowbase + 16 * ch + cq) * 2048 + 16 * g + 4 * rq;
            const bf16x4 ua_n = *(const bf16x4*)(up0 + (size_t)(ch < 30 ? ch + 2 : 31) * 16 * 2048);
#pragma unroll
            for (int jn = 0; jn < 4; ++jn) { f32x4 dr = __builtin_amdgcn_mfma_f32_16x16x16bf16_1k(ua, bb[jn], (f32x4){0.f, 0.f, 0.f, 0.f}, 0, 0, 0), di = __builtin_amdgcn_mfma_f32_16x16x16bf16_1k(ua, bb[jn + 4], (f32x4){0.f, 0.f, 0.f, 0.f}, 0, 0, 0);
#pragma unroll
                for (int e = 0; e < 4; ++e) BU[(4 * rq + e) * 64 + 16 * jn + cq] = pk2v(dr[e], di[e]); }
            LDS_WAIT();
            unsigned bwv[16];
#pragma unroll
            for (int tt = 0; tt < 16; ++tt) bwv[tt] = BU[tt * 64 + lane];
#pragma unroll
            for (int tt = 0; tt < 16; ++tt) { const unsigned bw = bwv[tt]; const f32x2 bu = (f32x2){bflo(bw), bfhi(bw)};
                const float nxr = __builtin_fmaf(ar, xr, __builtin_fmaf(-ai, xi, bu.x)), nxi = __builtin_fmaf(ar, xi, __builtin_fmaf(ai, xr, bu.y)); xr = nxr; xi = nxi;
                *(LAS unsigned*)(XL + tt * 272 + 4 * lane) = pk2(xr, xi); }
            LDS_WAIT();
            f32x4 a = (f32x4){0.f, 0.f, 0.f, 0.f};
#pragma unroll
            for (int ks = 0; ks < 4; ++ks) a = __builtin_amdgcn_mfma_f32_16x16x32_bf16(cf[ks], *(const LAS bf16x8*)(XL + cq * 272 + 64 * ks + 16 * rq), a, 0, 0, 0);
            const u32x2 uw = __builtin_bit_cast(u32x2, ua);
            const float y0 = a[0] + dsk[0] * bflo(uw.x), y1 = a[1] + dsk[1] * bfhi(uw.x), y2 = a[2] + dsk[2] * bflo(uw.y), y3 = a[3] + dsk[3] * bfhi(uw.y);
            u32x2 zw; zw.x = pk2(gelu_tanh(y0), gelu_tanh(y1)); zw.y = pk2(gelu_tanh(y2), gelu_tanh(y3));
            *(u32x2*)(Z + off) = zw;
            LDS_WAIT();
            ua = ub; ub = ua_n;
        }
        if (q == 3) *(f32x2*)(ssm_out + ((size_t)(b * 128 + g) * 64 + lane) * 2) = (f32x2){xr, xi};
        __syncthreads();
    }
}
__device__ __forceinline__ void ssm_sample(const Ctx& c, const float* USS, const float* h0, bf16* ZS, const float* lam_re, const float* lam_im, const float* log_dt, const float* b_re, const float* b_im,
                                           const float* c_re, const float* c_im, const float* d_skip, float* ssm_out) {
    const int gw = c.vcu * NWAVES + c.wave, NGW = c.G * NWAVES, lane = c.lane;
    for (int it = gw; it < 1024; it += NGW) {
        const int b = it >> 7, g = it & 127;
        const float lr = fminf(lam_re[g * 64 + lane], -1e-4f), lim = lam_im[g * 64 + lane], dt = __expf(log_dt[g]);
        const float mag = __expf(lr * dt); float sn, cs_; sincos_rr(lim * dt, sn, cs_);
        const float ar = mag * cs_, ai = mag * sn;
        const float den = 1.0f / (lr * lr + lim * lim), nr = ar - 1.0f;
        const float cr = (nr * lr + ai * lim) * den, ci = (ai * lr - nr * lim) * den;
        float u[16]; float sr = 0.f, si = 0.f;
#pragma unroll
        for (int k = 0; k < 16; ++k) { u[k] = USS[(size_t)b * 2048 + 16 * g + k]; sr += b_re[(size_t)(g * 64 + lane) * 16 + k] * u[k]; si += b_im[(size_t)(g * 64 + lane) * 16 + k] * u[k]; }
        const f32x2 hv = *(const f32x2*)(h0 + ((size_t)(b * 128 + g) * 64 + lane) * 2);
        const float xr = ar * hv.x - ai * hv.y + (cr * sr - ci * si), xi = ar * hv.y + ai * hv.x + (cr * si + ci * sr);
        *(f32x2*)(ssm_out + ((size_t)(b * 128 + g) * 64 + lane) * 2) = (f32x2){xr, xi};
        float myz = 0.f;
#pragma unroll
        for (int k = 0; k < 16; ++k) { const float y = wave_sum(c_re[(size_t)(g * 16 + k) * 64 + lane] * xr - c_im[(size_t)(g * 16 + k) * 64 + lane] * xi) + d_skip[16 * g + k] * u[k];
            const float z = gelu_tanh(y); myz = (lane == k) ? z : myz; }
        if (lane < 16) { ZS[(size_t)b * 2048 + 16 * g + lane] = (bf16)(pk2(myz, 0.f) & 0xffffu); const_cast<float*>(USS)[(size_t)b * 2048 + 16 * g + lane] = 0.f; }
    }
}


#define DIS_ATTN(...) __VA_ARGS__
#define DIS_ATTNS(...) __VA_ARGS__
#define DIS_SSM(...) __VA_ARGS__
#define DIS_SSMS(...) __VA_ARGS__
#define DIS_CONV(...) __VA_ARGS__
#define DIS_G1(...) __VA_ARGS__
#define DIS_G2(...) __VA_ARGS__
#define DIS_G3(...) __VA_ARGS__
#define DIS_G4(...) __VA_ARGS__


#define ATTN_FN attn_prompt
#define SSM_FN ssm_prompt

#ifndef ABL_ATTN_P
#define ABL_ATTN_P 1.0f
#endif
#ifndef ABL_ATTN_S
#define ABL_ATTN_S 1.0f
#endif
#ifndef ABL_SSM_P
#define ABL_SSM_P 1.0f
#endif
#ifndef ABL_SSM_S
#define ABL_SSM_S 1.0f
#endif
#ifndef ABL_FFN_P
#define ABL_FFN_P 1.0f
#endif
#ifndef ABL_FFN_S
#define ABL_FFN_S 1.0f
#endif
#ifndef ABL_S_A0
#define ABL_S_A0 1.0f
#endif
#ifndef ABL_S_A1
#define ABL_S_A1 1.0f
#endif
#ifndef ABL_S_S0
#define ABL_S_S0 1.0f
#endif
#ifndef ABL_S_S1
#define ABL_S_S1 1.0f
#endif
#ifndef ABL_S_F0
#define ABL_S_F0 1.0f
#endif
#ifndef ABL_S_F1
#define ABL_S_F1 1.0f
#endif
#ifndef ABL_S_F2
#define ABL_S_F2 1.0f
#endif
#ifndef ABL_S_F3
#define ABL_S_F3 1.0f
#endif
#define GEMM_FN gemm_phase
#ifndef ABL_P_A0
#define ABL_P_A0 1.0f
#endif
#ifndef ABL_P_A1
#define ABL_P_A1 1.0f
#endif
#ifndef ABL_P_S0
#define ABL_P_S0 1.0f
#endif
#ifndef ABL_P_S1
#define ABL_P_S1 1.0f
#endif
#ifndef ABL_P_F0
#define ABL_P_F0 1.0f
#endif
#ifndef ABL_P_F1
#define ABL_P_F1 1.0f
#endif
#ifndef ABL_P_F2
#define ABL_P_F2 1.0f
#endif
#ifndef ABL_P_F3
#define ABL_P_F3 1.0f
#endif
#define QKV_GEMM_CALL DIS_G1(pg8::GEMM_FN<pg8::EpiQKV, pg8::StaticOrder, true, true>(c.lds, g, S, E));
#define QKV_POST(LI)
#define GLU_EPI pg8::EpiGLU E{WSP(bf16, WS_M)}; DIS_G4(pg8::GEMM_FN<pg8::EpiGLU, pg8::StaticOrder, true, true>(c.lds, g, S, E));
#define GLU_POSTNORM(LI) postnorm_rows<false, false, true>(c, MP, args.out + O_YP, args.out + O_YP, WSP(const float, WS_M), D, NG(2 * (LI) + 1, 1), NG(2 * (LI) + 1, 2), WSP(bf16, WS_H), ((LI) == 0 ? ABL_P_S0 : ABL_P_S1));
#define UPGEMM_CALL pg8::GEMM_FN<pg8::EpiConv, pg8::StaticOrder, true, true>(c.lds, g, S, E);
struct Args { const float* in[24]; float* out; unsigned char* ws; int ph_lo, ph_hi; };
enum { I_XP = 0, I_XS, I_CK0, I_CK1, I_CK2, I_SSSM, I_SCONV, I_NG, I_WQKV, I_WO, I_WIN, I_LRE, I_LIM, I_LDT, I_BRE, I_BIM, I_CRE, I_CIM, I_DSK, I_WGLU, I_WUP, I_CW, I_CB, I_WDN };
#define WSP(T, off) ((T*)(args.ws + (off)))
#define SMP(T, off) ((T*)(args.ws + WS_SMP + (off)))
#define NG(i, j) (args.in[I_NG] + (size_t)((i) * 4 + (j)) * D)

#define PH_ATTN_LAYER(LI, PB) \
    if (IN((PB) + 0)) {     \
        const bf16* Wqkv = WSP(const bf16, WS_WQKV + (LI) * WQKV_L); \
        { pg8::Gemm g{WSP(const bf16, WS_H), Wqkv, MP, NQKV, D}; pg8::StaticOrder S; S.init(MP, NQKV, c.G, (int)blockIdx.x); \
          pg8::EpiQKV E{WSP(bf16, WS_Q), WSP(bf16, WS_VT), WSP(const float, WS_CS), args.out, (LI), 0.08838834764831845f * 1.4426950408889634f}; \
          QKV_GEMM_CALL } \
        skinny_gemm(c, SMP(const bf16, SM_HS), Wqkv, NQKV, D, SMP(float, SM_QKV), 128); \
        CONVQ_TAIL((PB) + 0, 128, CQ_CAPQ); \
    } \
    SEAM((PB) + 0); \
    QKV_POST((LI)) \
    if (IN((PB) + 1)) {     \
        DIS_ATTN(ATTN_FN(c, WSP(const bf16, WS_Q), WSP(const bf16, WS_K), WSP(const bf16, WS_VT), WSP(bf16, WS_OG), WSP(float, WS_LSE), WSP(float, WS_LL))); \
        DIS_ATTNS(attn_sample<0>(c, (LI), SMP(const float, SM_QKV), WSP(const float, WS_CS), args.in[I_CK0], SMP(float, SM_OSG), SMP(float, SM_LSE), args.out + O_KV0S)); \
        DIS_ATTNS(attn_sample<1>(c, (LI), SMP(const float, SM_QKV), WSP(const float, WS_CS), args.in[I_CK1], SMP(float, SM_OSG), SMP(float, SM_LSE), args.out + O_KV1S)); \
        DIS_ATTNS(attn_sample<2>(c, (LI), SMP(const float, SM_QKV), WSP(const float, WS_CS), args.in[I_CK2], SMP(float, SM_OSG), SMP(float, SM_LSE), args.out + O_KV2S)); \
    } \
    SEAM((PB) + 1); \
    if (IN((PB) + 2)) { merge_prompt(c, WSP(const bf16, WS_OG), WSP(const float, WS_LSE), WSP(const float, WS_LL), WSP(bf16, WS_O)); merge_sample(c, SMP(const float, SM_OSG), SMP(const float, SM_LSE), SMP(bf16, SM_OS)); } \
    SEAM((PB) + 2); \
    if (IN((PB) + 3)) {     \
        const bf16* Wo = WSP(const bf16, WS_WO + (LI) * WO_L); \
        { pg8::Gemm g{WSP(const bf16, WS_O), Wo, MP, D, AW}; pg8::StaticOrder S; S.init(MP, D, c.G, (int)blockIdx.x); \
          pg8::EpiBf16 E{WSP(bf16, WS_M), D}; \
          pg8::GEMM_FN<pg8::EpiBf16, pg8::StaticOrder, true, true>(c.lds, g, S, E); } \
        skinny_gemm(c, SMP(const bf16, SM_OS), Wo, D, AW, SMP(float, SM_MS)); \
    } \
    SEAM((PB) + 3); \
    if (IN((PB) + 4)) { \
        postnorm_rows<false, false, true>(c, MP, (LI) == 0 ? args.in[I_XP] : args.out + O_YP, args.out + O_YP, WSP(const float, WS_M), D, NG(2 * (LI), 1), NG(2 * (LI), 2), WSP(bf16, WS_H), ((LI) == 0 ? ABL_P_A0 : ABL_P_A1)); \
        postnorm_rows<false, true>(c, NS, (LI) == 0 ? args.in[I_XS] : args.out + O_YS, args.out + O_YS, SMP(const float, SM_MS), D, NG(2 * (LI), 1), NG(2 * (LI), 2), SMP(bf16, SM_HS), ((LI) == 0 ? ABL_S_A0 : ABL_S_A1)); \
    } \
    SEAM((PB) + 4);

#define PH_SSM_LAYER(LI, PB) \
    if (IN((PB) + 0)) {     \
        const bf16* Win = WSP(const bf16, WS_WIN + (LI) * WIN_L); \
        { pg8::Gemm g{WSP(const bf16, WS_H), Win, MP, D, D}; pg8::StaticOrder S; S.init(MP, D, c.G, (int)blockIdx.x); \
          pg8::EpiBf16 E{WSP(bf16, WS_USSM), D}; \
          DIS_G3(pg8::GEMM_FN<pg8::EpiBf16, pg8::StaticOrder, true, true>(c.lds, g, S, E)); } \
        skinny_gemm(c, SMP(const bf16, SM_HS), Win, D, D, SMP(float, SM_USSM)); \
    } \
    SEAM((PB) + 0); \
    if (IN((PB) + 1)) { \
        const size_t o1 = (size_t)(LI) * 128 * 64, o2 = (size_t)(LI) * 128, o3 = (size_t)(LI) * 128 * 64 * 16, o4 = (size_t)(LI) * 2048; \
        DIS_SSM(SSM_FN(c, WSP(const bf16, WS_USSM), WSP(bf16, WS_Z), args.in[I_LRE] + o1, args.in[I_LIM] + o1, args.in[I_LDT] + o2, args.in[I_BRE] + o3, args.in[I_BIM] + o3, args.in[I_CRE] + o3, args.in[I_CIM] + o3, args.in[I_DSK] + o4, args.out + O_SSMP + (LI) * SSMP_L)); \
        DIS_SSMS(ssm_sample(c, SMP(const float, SM_USSM), args.in[I_SSSM] + (size_t)(LI) * SSMS_L, SMP(bf16, SM_ZS), args.in[I_LRE] + o1, args.in[I_LIM] + o1, args.in[I_LDT] + o2, args.in[I_BRE] + o3, args.in[I_BIM] + o3, args.in[I_CRE] + o3, args.in[I_CIM] + o3, args.in[I_DSK] + o4, args.out + O_SSMS + (LI) * SSMS_L)); \
    } \
    SEAM((PB) + 1); \
    if (IN((PB) + 2)) {     \
        const bf16* Wglu = WSP(const bf16, WS_WGLU + (LI) * WGLU_L); \
        { pg8::Gemm g{WSP(const bf16, WS_Z), Wglu, MP, GLU2, D}; pg8::StaticOrder S; S.init(MP, GLU2, c.G, (int)blockIdx.x); \
          GLU_EPI } \
        skinny_gemm(c, SMP(const bf16, SM_ZS), Wglu, GLU2, D, SMP(float, SM_MS)); \
    } \
    SEAM((PB) + 2); \
    if (IN((PB) + 3)) { \
        GLU_POSTNORM((LI)) \
        postnorm_rows<true, true>(c, NS, args.out + O_YS, args.out + O_YS, SMP(const float, SM_MS), GLU2, NG(2 * (LI) + 1, 1), NG(2 * (LI) + 1, 2), SMP(bf16, SM_HS), ((LI) == 0 ? ABL_S_S0 : ABL_S_S1)); \
    } \
    SEAM((PB) + 3);

#define PH_FFN(I, FB) \
    if (IN((FB) + 0)) {     \
        const bf16* Wup = WSP(const bf16, WS_WUP + (I) * WUP_L); \
        { pg8::Gemm g{WSP(const bf16, WS_H), Wup, MP, FF2, D}; pg8::StaticOrder S; S.init(MP, FF2, c.G, (int)blockIdx.x); \
          pg8::EpiConv E{WSP(bf16, WS_ACT), args.in[I_CW] + (size_t)(I) * 3 * FF2, args.in[I_CB] + (size_t)(I) * FF2, WSP(float, WS_U), WSP(float, WS_U) + 64 * FF2, args.out + O_CONVP + (I) * CONVP_L, (PG8_LAS float*)(c.lds + 132096)}; \
          UPGEMM_CALL } \
        skinny_gemm(c, SMP(const bf16, SM_HS), Wup, FF2, D, SMP(float, SM_US), 96); \
        CONVQ_TAIL((FB) + 0, 96, CQ_CAPU); \
    } \
    SEAM((FB) + 0); \
    if (IN((FB) + 1)) { \
        conv_fixup(c, WSP(const float, WS_U), WSP(const float, WS_U) + 64 * FF2, WSP(bf16, WS_ACT), args.in[I_CW] + (size_t)(I) * 3 * FF2); \
        conv_sample(c, SMP(const float, SM_US), args.in[I_SCONV] + (size_t)(I) * CONVS_L, SMP(bf16, SM_ACT), args.in[I_CW] + (size_t)(I) * 3 * FF2, args.in[I_CB] + (size_t)(I) * FF2, args.out + O_CONVS + (I) * CONVS_L); \
    } \
    SEAM((FB) + 1); \
    if (IN((FB) + 2)) {     \
        const bf16* Wdn = WSP(const bf16, WS_WDN + (I) * WDN_L); \
        { pg8::Gemm g{WSP(const bf16, WS_ACT), Wdn, MP, D, FF}; pg8::StaticOrder S; S.init(MP, D, c.G, (int)blockIdx.x); \
          pg8::EpiBf16 E{WSP(bf16, WS_M), D}; \
          pg8::GEMM_FN<pg8::EpiBf16, pg8::StaticOrder, true, true>(c.lds, g, S, E); } \
        skinny_gemm(c, SMP(const bf16, SM_ACT), Wdn, D, FF, SMP(float, SM_MS)); \
    } \
    SEAM((FB) + 2); \
    if (IN((FB) + 3)) { \
        const float* g2 = ((I) < 3) ? NG((I) + 1, 0) : nullptr; \
        postnorm_rows<false, false, true>(c, MP, args.out + O_YP, args.out + O_YP, WSP(const float, WS_M), D, NG((I), 3), g2, WSP(bf16, WS_H), ((I) == 0 ? ABL_P_F0 : (I) == 1 ? ABL_P_F1 : (I) == 2 ? ABL_P_F2 : ABL_P_F3)); \
        postnorm_rows<false, true>(c, NS, args.out + O_YS, args.out + O_YS, SMP(const float, SM_MS), D, NG((I), 3), g2, SMP(bf16, SM_HS), ((I) == 0 ? ABL_S_F0 : (I) == 1 ? ABL_S_F1 : (I) == 2 ? ABL_S_F2 : ABL_S_F3)); \
    } \
    SEAM((FB) + 3);

__global__ void __launch_bounds__(NWAVES * 64, 2) fwd_kernel(Args args) {
    extern __shared__ __attribute__((aligned(16))) unsigned char lds_raw[];
    Ctx c; c.lds = (LAS unsigned char*)lds_raw; c.tid = threadIdx.x; c.lane = c.tid & 63; c.wave = __builtin_amdgcn_readfirstlane(c.tid >> 6);
    c.G = gridDim.x; { const int bx = blockIdx.x; c.vcu = (c.G % 8 == 0) ? (bx % 8) * (c.G / 8) + bx / 8 : bx; }
    volatile LAS unsigned* MISC = (volatile LAS unsigned*)(c.lds + MISC_OFF);
    if (c.tid < 32) MISC[c.tid] = 0u;
    __syncthreads();
    XcdBarrier bar = xcd_barrier_post((unsigned*)(args.ws + WS_CTL) + CW_BAR, MISC + 8);
    const int lo = args.ph_lo, hi = args.ph_hi;
#define IN(k) (lo <= (k) && (k) < hi)
#define DBG_STAMP(i) do { } while (0)
#define SEAM(k) do { CONVQ_SEAM(k); if (IN(k) && IN((k) + 1)) xcd_barrier(bar); DBG_STAMP((k) + 1); } while (0)
    DBG_STAMP(0);

    if (IN(0)) {
        CONVQ_RANGE(0, convq_need(1), c.vcu * NWAVES + c.wave, c.G * NWAVES, 0);
        build_cs(c, WSP(float, WS_CS));
        zero_f32(c, SMP(float, SM_QKV), 8 * NQKV); zero_f32(c, SMP(float, SM_MS), 8 * GLU2); zero_f32(c, SMP(float, SM_US), 8 * FF2); zero_f32(c, SMP(float, SM_USSM), 8 * D);
        prenorm_rows(c, MP, args.in[I_XP], args.in[I_NG], WSP(bf16, WS_H));
        prenorm_rows(c, NS, args.in[I_XS], args.in[I_NG], SMP(bf16, SM_HS));
    }
    SEAM(0);
    PH_ATTN_LAYER(0, 1)
    PH_FFN(0, 6)
    PH_SSM_LAYER(0, 10)
    PH_FFN(1, 14)
    PH_ATTN_LAYER(1, 18)
    PH_FFN(2, 23)
    PH_SSM_LAYER(1, 27)
    PH_FFN(3, 31)
#undef IN
#undef SEAM
}

#ifndef MK_PER_PHASE
#define MK_PER_PHASE 0
#endif
extern "C" void kernel_launch(void* const* d_in, const int* in_sizes, int n_in, void* d_out, int out_size, void* d_ws, size_t ws_size, hipStream_t stream) {
    static int grid = 0;
    if (grid == 0) {
        if (n_in != 24 || in_sizes[0] != MP * D || (size_t)out_size != O_END || ws_size < WS_END) {
            fprintf(stderr, "kernel_launch: shape mismatch: n_in %d in0 %d out %d ws %zu (need 24, %d, %zu, >= %zu); nothing launched\n", n_in, n_in > 0 ? in_sizes[0] : -1, out_size, ws_size, MP * D, (size_t)O_END, (size_t)WS_END); grid = -1; return; }
        { const long long exp_sz[24] = {(long long)MP * D, (long long)NS * D, 2LL * 8 * 128 * 2048, 2LL * 8 * 512 * 2048, 2LL * 8 * 2048 * 2048, 2LL * 8 * 128 * 64 * 2, 4LL * 8 * 2 * FF2, 4LL * 4 * D,
              2LL * D * NQKV, 2LL * AW * D, 2LL * D * D, 2LL * 128 * 64, 2LL * 128 * 64, 2LL * 128, 2LL * 128 * 64 * 16, 2LL * 128 * 64 * 16, 2LL * 128 * 16 * 64, 2LL * 128 * 16 * 64, 2LL * D, 2LL * D * GLU2,
              4LL * D * FF2, 4LL * 3 * FF2, 4LL * FF2, 4LL * FF * D};
          for (int i = 0; i < 24; ++i) if ((long long)in_sizes[i] != exp_sz[i]) { fprintf(stderr, "kernel_launch: input %d has %d elements, expected %lld; nothing launched\n", i, in_sizes[i], exp_sz[i]); grid = -1; return; } }
        int dev = 0, cus = 0, per_cu = 0;
        if (hipGetDevice(&dev) != hipSuccess || hipDeviceGetAttribute(&cus, hipDeviceAttributeMultiprocessorCount, dev) != hipSuccess) { fprintf(stderr, "kernel_launch: device query failed\n"); grid = -1; return; }
        if (hipFuncSetAttribute((const void*)fwd_kernel, hipFuncAttributeMaxDynamicSharedMemorySize, LDS_BYTES) != hipSuccess) { fprintf(stderr, "kernel_launch: hipFuncSetAttribute failed\n"); grid = -1; return; }
        if (hipOccupancyMaxActiveBlocksPerMultiprocessor(&per_cu, (const void*)fwd_kernel, NWAVES * 64, LDS_BYTES) != hipSuccess || per_cu < 1)
            fprintf(stderr, "kernel_launch: note: occupancy query reports %d workgroups per CU\n", per_cu);
        (void)hipGetLastError();
        grid = cus;
        if (grid != 256) { fprintf(stderr, "kernel_launch: %d CUs (built for 256); nothing launched\n", grid); grid = -1; return; }
    }
    if (grid < 0) return;
    if (hipMemsetAsync((char*)d_ws + WS_CTL, 0, CTL_ZERO_BYTES, stream) != hipSuccess) { fprintf(stderr, "kernel_launch: memset failed\n"); return; }
    Args a{};
    for (int i = 0; i < 24; ++i) a.in[i] = (const float*)d_in[i];
    a.out = (float*)d_out; a.ws = (unsigned char*)d_ws;
#if MK_PER_PHASE
    for (int p = 0; p < N_PHASES; ++p) { a.ph_lo = p; a.ph_hi = p + 1; hipLaunchKernelGGL(fwd_kernel, dim3(grid), dim3(NWAVES * 64), LDS_BYTES, stream, a); }
#else
    a.ph_lo = 0; a.ph_hi = N_PHASES;
    hipLaunchKernelGGL(fwd_kernel, dim3(grid), dim3(NWAVES * 64), LDS_BYTES, stream, a);
#endif
    const hipError_t le = hipPeekAtLastError();
    if (le != hipSuccess) fprintf(stderr, "kernel_launch: launch failed: %s\n", hipGetErrorName(le));
}
```
